# Optimizing an MI355X kernel written in HIP

```python
import jax, jax.numpy as jnp
from jax import lax
import numpy as np

D_MODEL = 1024
BATCH = 4
SEQ = 8192
DEPTH = 2

N_HEADS = 16
HEAD_DIM = D_MODEL // N_HEADS
N_A_LAYERS = DEPTH // 2
N_B_LAYERS = DEPTH - N_A_LAYERS
SB_Q_BLOCK = 128
MOBA_BLOCK = 256
MOBA_TOPK = 3
MOBA_Q_CHUNK = 64
N_GROUPS = 4
EXPERTS_PER_GROUP = 4
N_EXPERTS = N_GROUPS * EXPERTS_PER_GROUP
TOPK_IN_GROUP = 2
EXPERT_FF = 256
RMS_EPS = 1e-6
ALIBI_MAX_BIAS = 8.0

kernel_name = 'hybrid_yoco_stickbreak_moba_hmoe'


def rmsnorm(x, g):
    xf = x.astype(jnp.float32)
    y = xf * lax.rsqrt(jnp.mean(xf * xf, axis=-1, keepdims=True) + RMS_EPS)
    return (y * g.astype(jnp.float32)).astype(x.dtype)


def modulate(h, shift, scale):
    return h * (1.0 + scale[:, None, :]) + shift[:, None, :]


def split_heads(t):
    b, s, _ = t.shape
    return t.reshape(b, s, N_HEADS, HEAD_DIM).transpose(0, 2, 1, 3)


def merge_heads(t):
    b, h, s, d = t.shape
    return t.transpose(0, 2, 1, 3).reshape(b, s, h * d)


def alibi_slopes():
    return jnp.exp2(-ALIBI_MAX_BIAS * jnp.arange(1, N_HEADS + 1, dtype=jnp.float32) / N_HEADS)


def stick_breaking_attention(q, k, v):
    b, h, s, dh = q.shape
    nq = s // SB_Q_BLOCK
    scale = dh ** -0.5
    kpos = jnp.arange(s)
    qb = q.reshape(b, h, nq, SB_Q_BLOCK, dh).transpose(2, 0, 1, 3, 4)

    def block(args):
        qblk, i = args
        qpos = i * SB_Q_BLOCK + jnp.arange(SB_Q_BLOCK)
        z = jnp.einsum('bhqd,bhkd->bhqk', qblk, k).astype(jnp.float32) * scale
        past = kpos[None, :] < qpos[:, None]
        log_keep = jnp.where(past, jax.nn.log_sigmoid(-z), 0.0)
        suffix = lax.cumsum(log_keep, axis=3, reverse=True) - log_keep
        w = jnp.where(past, jnp.exp(jax.nn.log_sigmoid(z) + suffix), 0.0)
        return jnp.einsum('bhqk,bhkd->bhqd', w.astype(v.dtype), v)

    out = lax.map(block, (qb, jnp.arange(nq)))
    return out.transpose(1, 2, 0, 3, 4).reshape(b, h, s, dh)


def moba_attention(q, k_blocks, v_blocks, k_means, slopes):
    b, h, s, dh = q.shape
    nb = k_blocks.shape[2]
    topk = min(MOBA_TOPK, nb)
    nc = s // MOBA_Q_CHUNK
    scale = dh ** -0.5
    qc = q.reshape(b, h, nc, MOBA_Q_CHUNK, dh).transpose(2, 0, 1, 3, 4)
    blk_ids = jnp.arange(nb)
    in_blk = jnp.arange(MOBA_BLOCK)
    gather = jax.vmap(jax.vmap(lambda blocks, idx: blocks[idx]))

    def chunk(args):
        qblk, i = args
        qpos = i * MOBA_Q_CHUNK + jnp.arange(MOBA_Q_CHUNK)
        own = (i * MOBA_Q_CHUNK) // MOBA_BLOCK
        gate = jnp.einsum('bhqd,bhnd->bhqn', qblk, k_means).astype(jnp.float32)
        gate = jnp.where(blk_ids < own, gate, -jnp.inf)
        _, gidx = lax.top_k(gate, topk)
        valid = gidx < own
        ks = gather(k_blocks, gidx)
        vs = gather(v_blocks, gidx)
        ls = jnp.einsum('bhqd,bhqnkd->bhqnk', qblk, ks).astype(jnp.float32) * scale
        kpos_sel = gidx[..., None] * MOBA_BLOCK + in_blk
        dist_sel = (qpos[:, None, None] - kpos_sel).astype(jnp.float32)
        ls = ls - slopes[None, :, None, None, None] * dist_sel
        ls = jnp.where(valid[..., None], ls, -jnp.inf).reshape(b, h, MOBA_Q_CHUNK, topk * MOBA_BLOCK)
        k_own = lax.dynamic_index_in_dim(k_blocks, own, axis=2, keepdims=False)
        v_own = lax.dynamic_index_in_dim(v_blocks, own, axis=2, keepdims=False)
        lo = jnp.einsum('bhqd,bhkd->bhqk', qblk, k_own).astype(jnp.float32) * scale
        dist_own = qpos[:, None] - (own * MOBA_BLOCK + in_blk)[None, :]
        lo = jnp.where(dist_own >= 0,
                       lo - slopes[None, :, None, None] * dist_own.astype(jnp.float32),
                       -jnp.inf)
        p = jax.nn.softmax(jnp.concatenate([ls, lo], axis=-1), axis=-1)
        p_sel = p[..., :topk * MOBA_BLOCK].reshape(b, h, MOBA_Q_CHUNK, topk, MOBA_BLOCK)
        p_own = p[..., topk * MOBA_BLOCK:]
        return (jnp.einsum('bhqnk,bhqnkd->bhqd', p_sel.astype(vs.dtype), vs)
                + jnp.einsum('bhqk,bhkd->bhqd', p_own.astype(v_own.dtype), v_own))

    out = lax.map(chunk, (qc, jnp.arange(nc)))
    return out.transpose(1, 2, 0, 3, 4).reshape(b, h, s, dh)


def shared_kv(x, c, w_ada_kv, b_ada_kv, g_kv, w_kv):
    b, s, d = x.shape
    shift, scale = jnp.split(c @ w_ada_kv + b_ada_kv, 2, axis=-1)
    hkv = modulate(rmsnorm(x, g_kv), shift, scale)
    kv = hkv @ w_kv
    k = split_heads(kv[..., :d])
    v = split_heads(kv[..., d:])
    n_blocks = -(-s // MOBA_BLOCK)
    pad = n_blocks * MOBA_BLOCK - s
    k = jnp.pad(k, ((0, 0), (0, 0), (0, pad), (0, 0)))
    v = jnp.pad(v, ((0, 0), (0, 0), (0, pad), (0, 0)))
    k_blocks = k.reshape(b, N_HEADS, n_blocks, MOBA_BLOCK, HEAD_DIM)
    v_blocks = v.reshape(b, N_HEADS, n_blocks, MOBA_BLOCK, HEAD_DIM)
    k_means = jnp.mean(k_blocks.astype(jnp.float32), axis=3).astype(k.dtype)
    return k_blocks, v_blocks, k_means


def hier_moe(h, w_rg, b_rg, w_re, b_re, w_gate, w_up, w_down):
    b, s, d = h.shape
    t = h.reshape(b * s, d)
    n_tok = t.shape[0]
    tok = jnp.arange(n_tok)
    lg = (t @ w_rg + b_rg).astype(jnp.float32)
    pg = jax.nn.softmax(lg, axis=-1)
    g_sel = jnp.argmax(lg, axis=-1)
    p_g = pg[tok, g_sel][:, None]
    le = (t @ w_re + b_re).astype(jnp.float32).reshape(n_tok, N_GROUPS, EXPERTS_PER_GROUP)
    le_g = le[tok, g_sel]
    ve, ie = lax.top_k(le_g, TOPK_IN_GROUP)
    pe = jax.nn.softmax(ve, axis=-1) * p_g
    eid = g_sel[:, None] * EXPERTS_PER_GROUP + ie
    combine = jnp.sum(jax.nn.one_hot(eid, N_EXPERTS, dtype=jnp.float32) * pe[..., None], axis=1)
    hg = jnp.einsum('td,edf->tef', t, w_gate)
    hu = jnp.einsum('td,edf->tef', t, w_up)
    hid = jax.nn.silu(hg) * hu * combine[:, :, None].astype(t.dtype)
    out = jnp.einsum('tef,efd->td', hid, w_down)
    return out.reshape(b, s, d)


def setup_inputs(seed: int = 0) -> dict:
    key = jax.random.key(seed)
    ks = jax.random.split(key, 24)
    D = D_MODEL
    nA = max(N_A_LAYERS, 1)
    nB = max(N_B_LAYERS, 1)

    def nrm(k, shape, fan_in, gain=1.0):
        return jax.random.normal(k, shape, jnp.float32) * (gain * fan_in ** -0.5)

    def gain(k, shape):
        return 1.0 + 0.02 * jax.random.normal(k, shape, jnp.float32)

    def small(k, shape, s=0.01):
        return s * jax.random.normal(k, shape, jnp.float32)

    return {
        'x': jax.random.normal(ks[0], (BATCH, SEQ, D), jnp.float32),
        'c': jax.random.normal(ks[1], (BATCH, D), jnp.float32),
        'w_ada': nrm(ks[2], (DEPTH, D, 6 * D), D, 0.1),
        'b_ada': small(ks[3], (DEPTH, 6 * D)),
        'g_attn': gain(ks[4], (DEPTH, D)),
        'g_ffn': gain(ks[5], (DEPTH, D)),
        'w_qkv_a': nrm(ks[6], (nA, D, 3 * D), D),
        'w_o_a': nrm(ks[7], (nA, D, D), D),
        'w_ada_kv': nrm(ks[8], (D, 2 * D), D, 0.1),
        'b_ada_kv': small(ks[9], (2 * D,)),
        'g_kv': gain(ks[10], (D,)),
        'w_kv': nrm(ks[11], (D, 2 * D), D),
        'w_q_b': nrm(ks[12], (nB, D, D), D),
        'w_o_b': nrm(ks[13], (nB, D, D), D),
        'w_rg': nrm(ks[14], (DEPTH, D, N_GROUPS), D),
        'b_rg': small(ks[15], (DEPTH, N_GROUPS)),
        'w_re': nrm(ks[16], (DEPTH, D, N_EXPERTS), D),
        'b_re': small(ks[17], (DEPTH, N_EXPERTS)),
        'w_gate': nrm(ks[18], (DEPTH, N_EXPERTS, D, EXPERT_FF), D),
        'w_up': nrm(ks[19], (DEPTH, N_EXPERTS, D, EXPERT_FF), D),
        'w_down': nrm(ks[20], (DEPTH, N_EXPERTS, EXPERT_FF, D), EXPERT_FF),
        'g_final': gain(ks[21], (D,)),
    }


def reference(x, c, w_ada, b_ada, g_attn, g_ffn, w_qkv_a, w_o_a, w_ada_kv, b_ada_kv, g_kv, w_kv,
              w_q_b, w_o_b, w_rg, b_rg, w_re, b_re, w_gate, w_up, w_down, g_final):
    b, s, d = x.shape
    slopes = alibi_slopes()
    k_blocks = v_blocks = k_means = None
    for l in range(DEPTH):
        mod = c @ w_ada[l] + b_ada[l]
        sh_m, sc_m, gt_m, sh_f, sc_f, gt_f = jnp.split(mod, 6, axis=-1)
        h = modulate(rmsnorm(x, g_attn[l]), sh_m, sc_m)
        if l < N_A_LAYERS:
            qkv = (h @ w_qkv_a[l]).reshape(b, s, 3, N_HEADS, HEAD_DIM).transpose(2, 0, 3, 1, 4)
            o = merge_heads(stick_breaking_attention(qkv[0], qkv[1], qkv[2])) @ w_o_a[l]
        else:
            j = l - N_A_LAYERS
            q = split_heads(h @ w_q_b[j])
            o = merge_heads(moba_attention(q, k_blocks, v_blocks, k_means, slopes)) @ w_o_b[j]
        x = x + (1.0 + gt_m)[:, None, :] * o
        h = modulate(rmsnorm(x, g_ffn[l]), sh_f, sc_f)
        x = x + (1.0 + gt_f)[:, None, :] * hier_moe(h, w_rg[l], b_rg[l], w_re[l], b_re[l],
                                                   w_gate[l], w_up[l], w_down[l])
        if l == N_A_LAYERS - 1:
            k_blocks, v_blocks, k_means = shared_kv(x, c, w_ada_kv, b_ada_kv, g_kv, w_kv)
    return rmsnorm(x, g_final)
```

```cpp
#include <hip/hip_runtime.h>
#include <cstdio>
#include <cstdint>

constexpr int NB = 4, SEQ = 8192, DM = 1024, MT = NB * SEQ, NH = 16, HD = 64;
constexpr int NBLK = 32, MBLK = 256, NE = 16, EFF = 256;
constexpr float EPS = 1e-6f;
constexpr float LOG2E = 1.4426950408889634f;

__global__ void k_mod(const float* __restrict__ c, const float* __restrict__ W, const float* __restrict__ bias, float* __restrict__ out, int N) {
    const int n = blockIdx.x * blockDim.x + threadIdx.x;
    if (n >= N) return;
    float a0 = 0.f, a1 = 0.f, a2 = 0.f, a3 = 0.f;
    for (int k = 0; k < DM; ++k) {
        const float w = W[(size_t)k * N + n];
        a0 += c[k] * w; a1 += c[DM + k] * w; a2 += c[2 * DM + k] * w; a3 += c[3 * DM + k] * w;
    }
    const float bv = bias[n];
    out[n] = a0 + bv; out[N + n] = a1 + bv; out[2 * N + n] = a2 + bv; out[3 * N + n] = a3 + bv;
}

__device__ __forceinline__ float wave_sum(float v) {
#pragma unroll
    for (int o = 1; o < 64; o <<= 1) v += __shfl_xor(v, o);
    return v;
}

__global__ void k_rstd(const float* __restrict__ x, float* __restrict__ rstd) {
    const int row = blockIdx.x * 4 + (threadIdx.x >> 6), lane = threadIdx.x & 63;
    const float4* xr = (const float4*)(x + (size_t)row * DM) + lane;
    float s = 0.f;
#pragma unroll
    for (int j = 0; j < 4; ++j) { const float4 v = xr[64 * j]; s += v.x * v.x + v.y * v.y + v.z * v.z + v.w * v.w; }
    s = wave_sum(s);
    if (lane == 0) rstd[row] = rsqrtf(s * (1.f / DM) + EPS);
}

template <int NORM, int EPI>
__global__ void __launch_bounds__(256) k_gemm(const float* __restrict__ A, int lda, const float* __restrict__ W, int ldw, float* C, int ldc, int K,
                                              const float* __restrict__ rstd, const float* __restrict__ g, const float* __restrict__ sc, const float* __restrict__ sh, int ldmod,
                                              const float* base, const float* __restrict__ gate) {
    __shared__ float As[16][68];
    __shared__ float Bs[16][68];
    const int tid = threadIdx.x, tx = tid & 15, ty = tid >> 4;
    const int row0 = blockIdx.y * 64, col0 = blockIdx.x * 64;
    const int b = row0 / SEQ;
    float acc[4][4];
#pragma unroll
    for (int i = 0; i < 4; ++i)
#pragma unroll
        for (int j = 0; j < 4; ++j) acc[i][j] = 0.f;
    const int ar = tid >> 2, ak = (tid & 3) * 4;
    const int bk = tid >> 4, bn = (tid & 15) * 4;
    float rs = 1.f;
    if (NORM) rs = rstd[row0 + ar];
    for (int k0 = 0; k0 < K; k0 += 16) {
        float4 av = *(const float4*)(A + (size_t)(row0 + ar) * lda + k0 + ak);
        if (NORM) {
            const float4 gv = *(const float4*)(g + k0 + ak);
            const float4 sv = *(const float4*)(sc + (size_t)b * ldmod + k0 + ak);
            const float4 hv = *(const float4*)(sh + (size_t)b * ldmod + k0 + ak);
            av.x = av.x * rs * gv.x * (1.f + sv.x) + hv.x; av.y = av.y * rs * gv.y * (1.f + sv.y) + hv.y;
            av.z = av.z * rs * gv.z * (1.f + sv.z) + hv.z; av.w = av.w * rs * gv.w * (1.f + sv.w) + hv.w;
        }
        const float4 bv = *(const float4*)(W + (size_t)(k0 + bk) * ldw + col0 + bn);
        __syncthreads();
        As[ak][ar] = av.x; As[ak + 1][ar] = av.y; As[ak + 2][ar] = av.z; As[ak + 3][ar] = av.w;
        *(float4*)&Bs[bk][bn] = bv;
        __syncthreads();
#pragma unroll
        for (int kk = 0; kk < 16; ++kk) {
            const float4 a4 = *(const float4*)&As[kk][ty * 4];
            const float4 b4 = *(const float4*)&Bs[kk][tx * 4];
            const float aa[4] = {a4.x, a4.y, a4.z, a4.w}, bb[4] = {b4.x, b4.y, b4.z, b4.w};
#pragma unroll
            for (int i = 0; i < 4; ++i)
#pragma unroll
                for (int j = 0; j < 4; ++j) acc[i][j] += aa[i] * bb[j];
        }
    }
#pragma unroll
    for (int i = 0; i < 4; ++i) {
        const int r = row0 + ty * 4 + i, cc = col0 + tx * 4;
        float4 o = {acc[i][0], acc[i][1], acc[i][2], acc[i][3]};
        if (EPI == 1) {
            const float4 bs = *(const float4*)(base + (size_t)r * ldc + cc);
            const float4 gt = *(const float4*)(gate + (size_t)b * ldmod + cc);
            o.x = bs.x + (1.f + gt.x) * o.x; o.y = bs.y + (1.f + gt.y) * o.y; o.z = bs.z + (1.f + gt.z) * o.z; o.w = bs.w + (1.f + gt.w) * o.w;
        }
        *(float4*)(C + (size_t)r * ldc + cc) = o;
    }
}

__global__ void __launch_bounds__(256) k_sb(float* qkv) {
    const int idx = blockIdx.x * 256 + threadIdx.x;
    const int t = idx % SEQ, h = (idx / SEQ) % NH, b = idx / (SEQ * NH);
    float* qp = qkv + (size_t)(b * SEQ + t) * 3072 + h * HD;
    float q[HD], o[HD];
#pragma unroll
    for (int d = 0; d < HD; ++d) { q[d] = qp[d] * (0.125f * LOG2E); o[d] = 0.f; }
    float R = 0.f;
    for (int s = t - 1; s >= 0; --s) {
        const float* kp = qkv + (size_t)(b * SEQ + s) * 3072 + 1024 + h * HD;
        float z = 0.f;
#pragma unroll
        for (int d = 0; d < HD; ++d) z += q[d] * kp[d];
        z = fminf(z, 126.f);
        const float L = log2f(1.f + exp2f(z));
        const float Cc = R + L;
        const float w = exp2f(z - Cc);
        const float* vp = kp + 1024;
#pragma unroll
        for (int d = 0; d < HD; ++d) o[d] += w * vp[d];
        R = Cc;
        if (R > 152.f) break;
    }
#pragma unroll
    for (int d = 0; d < HD; ++d) qp[d] = o[d];
}

__global__ void k_kmeans(const float* __restrict__ qkv, float* __restrict__ km) {
    const int idx = blockIdx.x * 256 + threadIdx.x;
    const int col = idx % DM, blk = (idx / DM) % NBLK, b = idx / (DM * NBLK);
    const float* p = qkv + (size_t)(b * SEQ + blk * MBLK) * 3072 + 1024 + col;
    float s = 0.f;
    for (int r = 0; r < MBLK; ++r) s += p[(size_t)r * 3072];
    km[idx] = s * (1.f / MBLK);
}

__global__ void __launch_bounds__(256) k_moba(float* qkv, const float* __restrict__ km) {
    const int idx = blockIdx.x * 256 + threadIdx.x;
    const int t = idx % SEQ, h = (idx / SEQ) % NH, b = idx / (SEQ * NH);
    float* qp = qkv + (size_t)(b * SEQ + t) * 3072 + h * HD;
    float q[HD], o[HD];
#pragma unroll
    for (int d = 0; d < HD; ++d) { q[d] = qp[d]; o[d] = 0.f; }
    const int own = t / MBLK;
    float v0 = -INFINITY, v1 = -INFINITY, v2 = -INFINITY; int i0 = -1, i1 = -1, i2 = -1;
    for (int j = 0; j < own; ++j) {
        const float* kp = km + (size_t)(b * NBLK + j) * DM + h * HD;
        float gsc = 0.f;
#pragma unroll
        for (int d = 0; d < HD; ++d) gsc += q[d] * kp[d];
        if (gsc > v0) { v2 = v1; i2 = i1; v1 = v0; i1 = i0; v0 = gsc; i0 = j; }
        else if (gsc > v1) { v2 = v1; i2 = i1; v1 = gsc; i1 = j; }
        else if (gsc > v2) { v2 = gsc; i2 = j; }
    }
    const float slope = exp2f(-0.5f * (float)(h + 1));
    float m = -INFINITY, l = 0.f;
#pragma unroll
    for (int si = 0; si < 4; ++si) {
        const int j = si == 0 ? i0 : si == 1 ? i1 : si == 2 ? i2 : own;
        if (j < 0) continue;
        const int k_lo = j * MBLK, k_hi = (j == own) ? t : (k_lo + MBLK - 1);
        for (int s = k_lo; s <= k_hi; ++s) {
            const float* kp = qkv + (size_t)(b * SEQ + s) * 3072 + 1024 + h * HD;
            float z = 0.f;
#pragma unroll
            for (int d = 0; d < HD; ++d) z += q[d] * kp[d];
            z = z * 0.125f - slope * (float)(t - s);
            const float mn = fmaxf(m, z);
            const float al = expf(m - mn), p = expf(z - mn);
            l = l * al + p;
            const float* vp = kp + 1024;
#pragma unroll
            for (int d = 0; d < HD; ++d) o[d] = o[d] * al + p * vp[d];
            m = mn;
        }
    }
    const float inv = 1.f / l;
#pragma unroll
    for (int d = 0; d < HD; ++d) qp[d] = o[d] * inv;
}

__global__ void __launch_bounds__(256) k_moe(float* x, const float* __restrict__ gffn, const float* __restrict__ mod  ,
                                             const float* __restrict__ w_rg, const float* __restrict__ b_rg, const float* __restrict__ w_re, const float* __restrict__ b_re,
                                             const float* __restrict__ w_gate, const float* __restrict__ w_up, const float* __restrict__ w_down) {
    __shared__ float hs[DM];
    __shared__ float red[4];
    __shared__ float lg[20];
    __shared__ float hid[2][EFF];
    __shared__ int es[2];
    __shared__ float cs[2];
    const int row = blockIdx.x, tid = threadIdx.x, b = row / SEQ;
    float* xr = x + (size_t)row * DM;
    const float* md = mod + (size_t)b * 6144;
    float xv[4]; float ss = 0.f;
#pragma unroll
    for (int i = 0; i < 4; ++i) { xv[i] = xr[tid + 256 * i]; ss += xv[i] * xv[i]; }
    ss = wave_sum(ss);
    if ((tid & 63) == 0) red[tid >> 6] = ss;
    __syncthreads();
    const float rs = rsqrtf((red[0] + red[1] + red[2] + red[3]) * (1.f / DM) + EPS);
#pragma unroll
    for (int i = 0; i < 4; ++i) { const int k = tid + 256 * i; hs[k] = xv[i] * rs * gffn[k] * (1.f + md[4096 + k]) + md[3072 + k]; }
    __syncthreads();
    if (tid < 20) {
        float a = 0.f;
        if (tid < 4) { for (int k = 0; k < DM; ++k) a += hs[k] * w_rg[k * 4 + tid]; a += b_rg[tid]; }
        else { const int e = tid - 4; for (int k = 0; k < DM; ++k) a += hs[k] * w_re[k * 16 + e]; a += b_re[e]; }
        lg[tid] = a;
    }
    __syncthreads();
    if (tid == 0) {
        int gs = 0; float mx = lg[0];
        for (int j = 1; j < 4; ++j) if (lg[j] > mx) { mx = lg[j]; gs = j; }
        float den = 0.f;
        for (int j = 0; j < 4; ++j) den += expf(lg[j] - mx);
        const float pg = 1.f / den;
        const float* le = lg + 4 + gs * 4;
        int a0 = 0; float va = le[0];
        for (int j = 1; j < 4; ++j) if (le[j] > va) { va = le[j]; a0 = j; }
        int a1 = -1; float vb = -INFINITY;
        for (int j = 0; j < 4; ++j) if (j != a0 && le[j] > vb) { vb = le[j]; a1 = j; }
        const float e1 = expf(vb - va), dn = 1.f + e1;
        es[0] = gs * 4 + a0; es[1] = gs * 4 + a1; cs[0] = pg / dn; cs[1] = pg * e1 / dn;
    }
    __syncthreads();
    for (int s = 0; s < 2; ++s) {
        const int e = es[s];
        const float* wg = w_gate + (size_t)e * DM * EFF + tid;
        const float* wu = w_up + (size_t)e * DM * EFF + tid;
        float ga = 0.f, ua = 0.f;
        for (int k = 0; k < DM; ++k) { const float hv = hs[k]; ga += hv * wg[(size_t)k * EFF]; ua += hv * wu[(size_t)k * EFF]; }
        hid[s][tid] = ga / (1.f + expf(-ga)) * ua * cs[s];
    }
    __syncthreads();
#pragma unroll
    for (int i = 0; i < 4; ++i) {
        const int n = tid + 256 * i; float a = 0.f;
        for (int s = 0; s < 2; ++s) {
            const float* wd = w_down + (size_t)es[s] * EFF * DM + n;
            for (int f = 0; f < EFF; ++f) a += hid[s][f] * wd[(size_t)f * DM];
        }
        xr[n] = xv[i] + (1.f + md[5120 + n]) * a;
    }
}

__global__ void k_final(float* x, const float* __restrict__ g) {
    const int row = blockIdx.x * 4 + (threadIdx.x >> 6), lane = threadIdx.x & 63;
    float4* xr = (float4*)(x + (size_t)row * DM) + lane;
    float4 v[4]; float s = 0.f;
#pragma unroll
    for (int j = 0; j < 4; ++j) { v[j] = xr[64 * j]; s += v[j].x * v[j].x + v[j].y * v[j].y + v[j].z * v[j].z + v[j].w * v[j].w; }
    s = wave_sum(s);
    const float rs = rsqrtf(s * (1.f / DM) + EPS);
#pragma unroll
    for (int j = 0; j < 4; ++j) { const float4 gv = ((const float4*)g)[lane + 64 * j]; float4 o = {v[j].x * rs * gv.x, v[j].y * rs * gv.y, v[j].z * rs * gv.z, v[j].w * rs * gv.w}; xr[64 * j] = o; }
}

extern "C" void kernel_launch(void* const* d_in, const int* in_sizes, int n_in, void* d_out, int out_size, void* d_ws, size_t ws_size, hipStream_t stream) {
    const float* x = (const float*)d_in[0];      const float* c = (const float*)d_in[1];
    const float* w_ada = (const float*)d_in[2];  const float* b_ada = (const float*)d_in[3];
    const float* g_attn = (const float*)d_in[4]; const float* g_ffn = (const float*)d_in[5];
    const float* w_qkv_a = (const float*)d_in[6]; const float* w_o_a = (const float*)d_in[7];
    const float* w_ada_kv = (const float*)d_in[8]; const float* b_ada_kv = (const float*)d_in[9];
    const float* g_kv = (const float*)d_in[10];  const float* w_kv = (const float*)d_in[11];
    const float* w_q_b = (const float*)d_in[12]; const float* w_o_b = (const float*)d_in[13];
    const float* w_rg = (const float*)d_in[14];  const float* b_rg = (const float*)d_in[15];
    const float* w_re = (const float*)d_in[16];  const float* b_re = (const float*)d_in[17];
    const float* w_gate = (const float*)d_in[18]; const float* w_up = (const float*)d_in[19];
    const float* w_down = (const float*)d_in[20]; const float* g_final = (const float*)d_in[21];
    float* out = (float*)d_out;
    char* ws = (char*)d_ws;
    float* qkv = (float*)ws;
    float* mod = (float*)(ws + (size_t)MT * 3072 * 4);
    float* modkv = mod + 2 * 4 * 6144;
    float* rstd = modkv + 4 * 2048;
    float* km = rstd + MT;

    k_mod<<<6144 / 256, 256, 0, stream>>>(c, w_ada, b_ada, mod, 6144);
    k_mod<<<6144 / 256, 256, 0, stream>>>(c, w_ada + (size_t)DM * 6144, b_ada + 6144, mod + 4 * 6144, 6144);
    k_mod<<<2048 / 256, 256, 0, stream>>>(c, w_ada_kv, b_ada_kv, modkv, 2048);
    const float* mod0 = mod; const float* mod1 = mod + 4 * 6144;
    k_rstd<<<MT / 4, 256, 0, stream>>>(x, rstd);
    k_gemm<1, 0><<<dim3(3072 / 64, MT / 64), 256, 0, stream>>>(x, DM, w_qkv_a, 3072, qkv, 3072, DM, rstd, g_attn, mod0 + 1024, mod0, 6144, nullptr, nullptr);
    k_sb<<<NB * NH * SEQ / 256, 256, 0, stream>>>(qkv);
    k_gemm<0, 1><<<dim3(DM / 64, MT / 64), 256, 0, stream>>>(qkv, 3072, w_o_a, DM, out, DM, DM, nullptr, nullptr, nullptr, nullptr, 6144, x, mod0 + 2048);
    k_moe<<<MT, 256, 0, stream>>>(out, g_ffn, mod0, w_rg, b_rg, w_re, b_re, w_gate, w_up, w_down);
    k_rstd<<<MT / 4, 256, 0, stream>>>(out, rstd);
    k_gemm<1, 0><<<dim3(2048 / 64, MT / 64), 256, 0, stream>>>(out, DM, w_kv, 2048, qkv + 1024, 3072, DM, rstd, g_kv, modkv + 1024, modkv, 2048, nullptr, nullptr);
    k_kmeans<<<NB * NBLK * DM / 256, 256, 0, stream>>>(qkv, km);
    k_gemm<1, 0><<<dim3(DM / 64, MT / 64), 256, 0, stream>>>(out, DM, w_q_b, DM, qkv, 3072, DM, rstd, g_attn + DM, mod1 + 1024, mod1, 6144, nullptr, nullptr);
    k_moba<<<NB * NH * SEQ / 256, 256, 0, stream>>>(qkv, km);
    k_gemm<0, 1><<<dim3(DM / 64, MT / 64), 256, 0, stream>>>(qkv, 3072, w_o_b, DM, out, DM, DM, nullptr, nullptr, nullptr, nullptr, 6144, out, mod1 + 2048);
    k_moe<<<MT, 256, 0, stream>>>(out, g_ffn + DM, mod1, w_rg + DM * 4, b_rg + 4, w_re + DM * 16, b_re + 16,
                                  w_gate + (size_t)NE * DM * EFF, w_up + (size_t)NE * DM * EFF, w_down + (size_t)NE * EFF * DM);
    k_final<<<MT / 4, 256, 0, stream>>>(out, g_final);
}
```

```cpp
#include <hip/hip_runtime.h>
#include <cstdio>
#include <cstdint>

#define GAS __attribute__((address_space(1)))
#define LAS __attribute__((address_space(3)))
typedef _Float16 f16;
typedef _Float16 f16x2 __attribute__((ext_vector_type(2)));
typedef _Float16 f16x4 __attribute__((ext_vector_type(4)));
typedef _Float16 f16x8 __attribute__((ext_vector_type(8)));
typedef float f32x2 __attribute__((ext_vector_type(2)));
typedef float f32x4 __attribute__((ext_vector_type(4)));
typedef float f32x16 __attribute__((ext_vector_type(16)));
typedef unsigned u32x2 __attribute__((ext_vector_type(2)));
typedef unsigned u32x4 __attribute__((ext_vector_type(4)));

constexpr int NB = 4, SEQ = 8192, DM = 1024, MT = NB * SEQ, NH = 16, HD = 64;
constexpr int NBLK = 32, MBLK = 256, NE = 16, EFF = 256, NCLS = 24;
constexpr float EPS = 1e-6f;
constexpr float LOG2E = 1.4426950408889634f;
constexpr float QSCALE = 0.125f * LOG2E;
constexpr int NWAVES = 8, NTHREADS = 512;

__device__ __forceinline__ unsigned pkh(float lo, float hi) { f32x2 v = {lo, hi}; f16x2 h = __builtin_convertvector(v, f16x2); return __builtin_bit_cast(unsigned, h); }
__device__ __forceinline__ float wave_sum(float v) {
#pragma unroll
    for (int o = 1; o < 64; o <<= 1) v += __shfl_xor(v, o);
    return v;
}

namespace pg8 {
constexpr int BM = 256, BK = 64, HALF = 128, HTB = HALF * BK * 2, STAGE_BYTES = 8 * HTB, NXCD = 8, WGM = 8;
__host__ __device__ __forceinline__ int lds_byte(int r, int c) { const int st = (r >> 4) * 2 + (c >> 5), rr = r & 15, cc = c & 31, ob = rr * 64 + cc * 2; return st * 1024 + (ob ^ (((ob >> 9) & 1) << 5)); }
__host__ __device__ __forceinline__ void stage_rc(int b, int& R, int& C) { const int st = b / 1024, sb = b % 1024, swz = sb ^ (((sb >> 9) & 1) << 5); R = (st >> 1) * 16 + swz / 64; C = (st & 1) * 32 + (swz % 64) / 2; }
__host__ __device__ __forceinline__ int perm32(int rho) { const int n = rho >> 4, i = rho & 15; return 8 * (i >> 2) + 4 * n + (i & 3); }

struct Unit { int pm, pn, cls, tin; };
struct Gemm { const char* A; const char* Bt; int K, lda, ldb; };

struct StaticOrder {
    int nM, nN, nwg, G, c, lda2, ldb2;
    __device__ __forceinline__ void init(int M, int N, int G_, int c_, int lda, int ldb) { nM = M / BM; nN = N / BM; nwg = nM * nN; G = G_; c = c_; lda2 = lda * 2; ldb2 = ldb * 2; }
    __device__ __forceinline__ bool next(int i, Unit& u) const {
        const long L = (long)i * G + c; if (L >= nwg) return false;
        int wgid = (int)L; { const int q = nwg / NXCD, r = nwg % NXCD, xcd = wgid % NXCD, off = wgid / NXCD; wgid = (xcd < r ? xcd * (q + 1) : r * (q + 1) + (xcd - r) * q) + off; }
        const int nig = WGM * nN, gid = wgid / nig, fm = gid * WGM, gsz = (nM - fm) < WGM ? (nM - fm) : WGM;
        u.pm = fm + ((wgid % nig) % gsz); u.pn = (wgid % nig) / gsz; u.cls = 0; u.tin = 0; return true;
    }
    __device__ __forceinline__ size_t a_off(const Unit& u) const { return (size_t)u.pm * BM * lda2; }
    __device__ __forceinline__ size_t b_off(const Unit& u) const { return (size_t)u.pn * BM * ldb2; }
    __device__ __forceinline__ int row_tok(const Unit&, int) const { return 0; }
};

template <class Epi, class Sched, bool ALIGN_EPI, bool GATHER>
__device__ __forceinline__ void gemm_phase(LAS unsigned char* lds, const Gemm g, const Sched& S, const Epi& E) {
    const int tid = threadIdx.x, wid = __builtin_amdgcn_readfirstlane(tid >> 6), lane = tid & 63, wr = wid >> 2, wc = wid & 3, fr = lane & 15, fq = lane >> 4;
    const int K = g.K, nt = K / BK;
    int Rr[2], Cc[2];
    unsigned cva0[2], cva1[2], nva0[2], nva1[2], voffB[2];
#pragma unroll
    for (int i = 0; i < 2; ++i) { int R, C; stage_rc(tid * 16 + i * 8192, R, C); Rr[i] = R; Cc[i] = C; const int Rb = Epi::PERM ? ((R & ~31) + perm32(R & 31)) : R;
        cva0[i] = (unsigned)(R * g.lda + C) * 2u; cva1[i] = (unsigned)((R + HALF) * g.lda + C) * 2u; nva0[i] = cva0[i]; nva1[i] = cva1[i];
        voffB[i] = (unsigned)(Rb * g.ldb + C) * 2u; }
    const size_t kstep = (size_t)(BK * 2);
    const size_t hstepB = (size_t)HALF * g.ldb * 2;
    const unsigned ldsw = (unsigned)wid * 1024u;
    const int aoff = lds_byte(wr * 64 + fr, fq * 8), boff = lds_byte(wc * 32 + fr, fq * 8);
#define PG8_SA(b, h) (((b) * 2 + (h)) * HTB)
#define PG8_SB(b, h) ((4 + (b) * 2 + (h)) * HTB)
#define PG8_STAGE(bufoff, gbase, voff) do { _Pragma("unroll") for (int _i = 0; _i < 2; ++_i) \
        __builtin_amdgcn_global_load_lds((const unsigned*)((const char*)(gbase) + (voff)[_i]), (LAS unsigned*)(lds + (bufoff) + ldsw + _i * 8192), 16, 0, 0); } while (0)
#define PG8_LDA(dst, b, h) do { _Pragma("unroll") for (int m = 0; m < 4; ++m) _Pragma("unroll") for (int k = 0; k < 2; ++k) dst[m][k] = *(const LAS f16x8*)(lds + PG8_SA(b, h) + aoff + m * 2048 + k * 1024); } while (0)
#define PG8_LDB(dst, b, h) do { _Pragma("unroll") for (int n = 0; n < 2; ++n) _Pragma("unroll") for (int k = 0; k < 2; ++k) dst[n][k] = *(const LAS f16x8*)(lds + PG8_SB(b, h) + boff + n * 2048 + k * 1024); } while (0)
#define PG8_MMA(ai, bj, At, Bt) do { __builtin_amdgcn_s_setprio(1); _Pragma("unroll") for (int m = 0; m < 4; ++m) _Pragma("unroll") for (int n = 0; n < 2; ++n) _Pragma("unroll") for (int k = 0; k < 2; ++k) \
        acc[ai][bj][m][n] = __builtin_amdgcn_mfma_f32_16x16x32_f16(Bt[n][k], At[m][k], acc[ai][bj][m][n], 0, 0, 0); __builtin_amdgcn_s_setprio(0); } while (0)
#define PG8_WAIT_V(n) asm volatile("s_waitcnt vmcnt(" #n ")" ::: "memory")
#define PG8_WAIT_L(n) asm volatile("s_waitcnt lgkmcnt(" #n ")" ::: "memory")
#define PG8_BAR __builtin_amdgcn_s_barrier()
#define PG8_SCHED __builtin_amdgcn_sched_barrier(0)
#define PG8_GATHER_V(dst0, dst1, U) do { _Pragma("unroll") for (int _i = 0; _i < 2; ++_i) { \
        dst0[_i] = (unsigned)(S.row_tok(U, Rr[_i]) * g.lda + Cc[_i]) * 2u; dst1[_i] = (unsigned)(S.row_tok(U, Rr[_i] + HALF) * g.lda + Cc[_i]) * 2u; } } while (0)
    Unit cur, nxt; int ui = 0;
    if (!S.next(0, cur)) return;
    f32x4 acc[2][2][4][2];
#pragma unroll
    for (int a = 0; a < 2; ++a)
#pragma unroll
        for (int b = 0; b < 2; ++b)
#pragma unroll
            for (int m = 0; m < 4; ++m)
#pragma unroll
                for (int n = 0; n < 2; ++n) acc[a][b][m][n] = (f32x4){0.f, 0.f, 0.f, 0.f};
    f16x8 At[4][2], B0[2][2], B1[2][2];
    if constexpr (GATHER) { PG8_GATHER_V(cva0, cva1, cur); }
    const char* cA = g.A + (GATHER ? (size_t)0 : S.a_off(cur)); const char* cB = g.Bt + S.b_off(cur);
    PG8_STAGE(PG8_SB(0, 0), cB, voffB); PG8_STAGE(PG8_SB(0, 1), cB + hstepB, voffB); PG8_STAGE(PG8_SA(0, 0), cA, cva0); PG8_STAGE(PG8_SA(0, 1), cA, cva1);
    if (wr == 1) PG8_BAR;
    PG8_WAIT_V(2); PG8_BAR;
    PG8_STAGE(PG8_SB(1, 0), cB + kstep, voffB); PG8_STAGE(PG8_SA(1, 0), cA + kstep, cva0); PG8_STAGE(PG8_SB(1, 1), cB + hstepB + kstep, voffB);
    PG8_WAIT_V(6); PG8_BAR;
    for (;;) {
        const bool has_next = S.next(ui + 1, nxt);
        const char* nA = has_next ? g.A + (GATHER ? (size_t)0 : S.a_off(nxt)) : cA; const char* nB = has_next ? g.Bt + S.b_off(nxt) : cB;
        if constexpr (GATHER) { if (has_next) { PG8_GATHER_V(nva0, nva1, nxt); } else {
#pragma unroll
            for (int i = 0; i < 2; ++i) { nva0[i] = cva0[i]; nva1[i] = cva1[i]; } } }
        for (int t = 0; t < nt; t += 2) {
            const bool last = (t == nt - 2);
            const char* a1 = cA + (size_t)(t + 1) * kstep;
            const char* a2 = last ? nA : cA + (size_t)(t + 2) * kstep; const char* b2 = last ? nB : cB + (size_t)(t + 2) * kstep;
            const char* a3 = a2 + kstep; const char* b3 = b2 + kstep;
            unsigned w0[2], w1[2];
#pragma unroll
            for (int i = 0; i < 2; ++i) { w0[i] = (GATHER && last) ? nva0[i] : cva0[i]; w1[i] = (GATHER && last) ? nva1[i] : cva1[i]; }
            PG8_LDB(B0, 0, 0); PG8_LDB(B1, 0, 1); PG8_SCHED; PG8_LDA(At, 0, 0); PG8_STAGE(PG8_SA(1, 1), a1, cva1);
            PG8_WAIT_V(8); PG8_WAIT_L(0); PG8_BAR; PG8_MMA(0, 0, At, B0); PG8_MMA(0, 1, At, B1); PG8_BAR; PG8_SCHED;
            PG8_LDA(At, 0, 1); PG8_STAGE(PG8_SB(0, 0), b2, voffB); PG8_STAGE(PG8_SB(0, 1), b2 + hstepB, voffB); PG8_STAGE(PG8_SA(0, 0), a2, w0);
            PG8_WAIT_V(8); PG8_WAIT_L(0); PG8_BAR; PG8_MMA(1, 0, At, B0); PG8_MMA(1, 1, At, B1); PG8_BAR; PG8_SCHED;
            PG8_LDB(B0, 1, 0); PG8_LDB(B1, 1, 1); PG8_SCHED; PG8_LDA(At, 1, 0); PG8_STAGE(PG8_SA(0, 1), a2, w1);
            PG8_WAIT_V(8); PG8_WAIT_L(0); PG8_BAR; PG8_MMA(0, 0, At, B0); PG8_MMA(0, 1, At, B1); PG8_BAR; PG8_SCHED;
            PG8_LDA(At, 1, 1); PG8_STAGE(PG8_SB(1, 0), b3, voffB); PG8_STAGE(PG8_SB(1, 1), b3 + hstepB, voffB); PG8_STAGE(PG8_SA(1, 0), a3, w0);
            PG8_WAIT_V(8); PG8_WAIT_L(0); PG8_BAR; PG8_MMA(1, 0, At, B0); PG8_MMA(1, 1, At, B1); PG8_BAR; PG8_SCHED;
        }
        if constexpr (ALIGN_EPI) { if (wr == 0) PG8_BAR; }
        E(acc, cur, wr, wc, fr, fq);
        if (!has_next) break;
#pragma unroll
        for (int a = 0; a < 2; ++a)
#pragma unroll
            for (int b = 0; b < 2; ++b)
#pragma unroll
                for (int m = 0; m < 4; ++m)
#pragma unroll
                    for (int n = 0; n < 2; ++n) acc[a][b][m][n] = (f32x4){0.f, 0.f, 0.f, 0.f};
        cur = nxt; cA = nA; cB = nB; ++ui;
        if constexpr (GATHER) {
#pragma unroll
            for (int i = 0; i < 2; ++i) { cva0[i] = nva0[i]; cva1[i] = nva1[i]; } }
        if constexpr (ALIGN_EPI) { if (wr == 1) PG8_BAR; }
    }
    PG8_WAIT_V(0);
    if constexpr (!ALIGN_EPI) { if (wr == 0) PG8_BAR; }
    PG8_BAR;
#undef PG8_SA
#undef PG8_SB
#undef PG8_STAGE
#undef PG8_LDA
#undef PG8_LDB
#undef PG8_MMA
#undef PG8_WAIT_V
#undef PG8_WAIT_L
#undef PG8_BAR
#undef PG8_SCHED
#undef PG8_GATHER_V
}
}
constexpr size_t MiB = 1u << 20;
constexpr size_t WS_CTL = 0, CTL_ZERO_BYTES = 1 * MiB;
constexpr size_t WS_MOD = 1 * MiB;
constexpr size_t WS_LIST = 2 * MiB;
constexpr size_t WS_CW = 5 * MiB;
constexpr size_t WS_KMS = 6 * MiB;
constexpr size_t WS_WQKV0 = 8 * MiB, WS_WO0 = 14 * MiB, WS_WKV1 = 16 * MiB, WS_WQ1 = 20 * MiB, WS_WO1 = 22 * MiB;
constexpr size_t WS_WGU = 24 * MiB;
constexpr size_t WS_WD2 = 56 * MiB;
constexpr size_t WS_A1 = 104 * MiB, WS_A2 = 168 * MiB, WS_A3 = 232 * MiB, WS_A4 = 296 * MiB, WS_A5 = 360 * MiB;
constexpr size_t WS_HID = 424 * MiB;
constexpr size_t WS_END = 464 * MiB;
constexpr int CW_BAR = 4096;
constexpr int CW_CNT = 64;

constexpr int RING_OFF = 0, RING_BYTES = 131072;
constexpr int LDSCTL_OFF = RING_BYTES, MISC_OFF = LDSCTL_OFF + 320;
constexpr int LDS_BYTES = 147456;

#define XB_TMO      128
#define XB_XCNT(j)  (256  + 64 * (j))
#define XB_XSUB(j)  (1280 + 64 * (j))
#define XB_XGEN(j)  (2304 + 64 * (j))
#define XB_TOP      3328
#define XB_TOPGEN   3392
#define XCD_BAR_WORDS 3456
#define XB_SPIN_CAP (1u << 18)
__device__ __forceinline__ unsigned xb_ld(unsigned* p)              { return __hip_atomic_load(p, __ATOMIC_RELAXED, __HIP_MEMORY_SCOPE_AGENT); }
__device__ __forceinline__ unsigned xb_add(unsigned* p, unsigned v) { return __hip_atomic_fetch_add(p, v, __ATOMIC_RELAXED, __HIP_MEMORY_SCOPE_AGENT); }
__device__ __forceinline__ unsigned xb_xcc_id() { return (unsigned)__builtin_amdgcn_s_getreg((3 << 11) | 20) & 0xFu; }
#define XB_SPIN(cond, bar) do { unsigned _sp = 0; while (cond) { __builtin_amdgcn_s_sleep(1); \
    if ((++_sp & 255u) == 0u) { if (xb_ld(&(bar)[XB_TMO])) break; if (_sp > XB_SPIN_CAP) { atomicAdd(&(bar)[XB_TMO], 1u); break; } } } } while (0)
struct XcdBarrier { unsigned* bar; unsigned x; volatile LAS unsigned* st; };
__device__ __forceinline__ XcdBarrier xcd_barrier_post(unsigned* bar, volatile LAS unsigned* st) {
    XcdBarrier b; b.bar = bar; b.x = xb_xcc_id(); b.st = st;
    if (threadIdx.x == 0) (void)xb_add(&bar[XB_XCNT(b.x)], 1u);
    return b;
}
__device__ __forceinline__ void xcd_barrier_complete(unsigned* bar, unsigned x, unsigned& nloc, unsigned& nx) {
    const unsigned G = gridDim.x * gridDim.y * gridDim.z;
    unsigned sum, cnt, mine, sp = 0u;
    for (;;) {
        sum = 0u; cnt = 0u; mine = 0u;
#pragma unroll
        for (unsigned j = 0; j < 16; ++j) { const unsigned c = xb_ld(&bar[XB_XCNT(j)]); sum += c; cnt += (c > 0u) ? 1u : 0u; mine = (j == x) ? c : mine; }
        if (sum == G) break;
        __builtin_amdgcn_s_sleep(1);
        if ((++sp & 255u) == 0u) { if (xb_ld(&bar[XB_TMO])) break; if (sp > XB_SPIN_CAP) { atomicAdd(&bar[XB_TMO], 1u); break; } }
    }
    nloc = mine > 0u ? mine : 1u; nx = cnt > 0u ? cnt : 1u;
}
__device__ __forceinline__ void xcd_barrier(const XcdBarrier& b) {
    asm volatile("s_waitcnt vmcnt(0)" ::: "memory");
    __syncthreads();
    if (threadIdx.x == 0) {
        unsigned* bar = b.bar;
        __builtin_amdgcn_s_waitcnt(0);
        unsigned nloc = b.st[0], nx = b.st[1];
        if (nloc == 0u) { xcd_barrier_complete(bar, b.x, nloc, nx); b.st[0] = nloc; b.st[1] = nx; }
        const unsigned old = xb_add(&bar[XB_XSUB(b.x)], 1u);
        const unsigned gen = old / nloc;
        if (old + 1u == (gen + 1u) * nloc) {
            __builtin_amdgcn_fence(__ATOMIC_RELEASE, "agent");
            asm volatile("s_waitcnt vmcnt(0)" ::: "memory");
            const unsigned og = xb_add(&bar[XB_TOP], 1u);
            const unsigned tg = og / nx;
            if (og + 1u == (tg + 1u) * nx) xb_add(&bar[XB_TOPGEN], 1u);
            else XB_SPIN(xb_ld(&bar[XB_TOPGEN]) == tg, bar);
            __builtin_amdgcn_fence(__ATOMIC_ACQUIRE, "agent");
            xb_add(&bar[XB_XGEN(b.x)], 1u);
            asm volatile("s_waitcnt vmcnt(0)" ::: "memory");
        } else {
            XB_SPIN(xb_ld(&bar[XB_XGEN(b.x)]) == gen, bar);
            __builtin_amdgcn_fence(__ATOMIC_ACQUIRE, "agent");
            asm volatile("s_waitcnt vmcnt(0)" ::: "memory");
        }
    }
    __syncthreads();
}

using pg8::Unit; using pg8::BM; using pg8::HALF;
struct EpiF16 {
    static constexpr bool PERM = true;
    f16* O; int ldc; int split_cols; size_t split_stride; int qcols; float qscale;
    __device__ __forceinline__ void operator()(const f32x4 (&acc)[2][2][4][2], const Unit& u, int wr, int wc, int fr, int fq) const {
        const int row0 = u.pm * BM + wr * 64 + fr; int colt = u.pn * BM; f16* base = O;
        const float sc = (colt < qcols) ? qscale : 1.f;
        if (split_cols) { const int t = colt / split_cols; base += (size_t)t * split_stride; colt -= t * split_cols; }
        const int col0 = colt + wc * 32 + 8 * fq;
#pragma unroll
        for (int ai = 0; ai < 2; ++ai)
#pragma unroll
            for (int m = 0; m < 4; ++m) { f16* rowp = base + (size_t)(row0 + ai * HALF + m * 16) * ldc + col0;
#pragma unroll
                for (int bj = 0; bj < 2; ++bj) { const f32x4 v0 = acc[ai][bj][m][0] * sc, v1 = acc[ai][bj][m][1] * sc;
                    u32x4 w; w.x = pkh(v0[0], v0[1]); w.y = pkh(v0[2], v0[3]); w.z = pkh(v1[0], v1[1]); w.w = pkh(v1[2], v1[3]);
                    *(u32x4*)(rowp + bj * HALF) = w; } }
    }
};
struct EpiKV1 {
    static constexpr bool PERM = true;
    f16* O; int ldc; int split_cols; size_t split_stride; float* kms;
    __device__ __forceinline__ void operator()(const f32x4 (&acc)[2][2][4][2], const Unit& u, int wr, int wc, int fr, int fq) const {
        const int row0 = u.pm * BM + wr * 64 + fr; int colt = u.pn * BM; f16* base = O;
        const bool isk = colt < DM; const int kcol0 = colt + wc * 32 + 8 * fq;
        if (split_cols) { const int t = colt / split_cols; base += (size_t)t * split_stride; colt -= t * split_cols; }
        const int col0 = colt + wc * 32 + 8 * fq;
        f32x4 cs[2][2];
#pragma unroll
        for (int bj = 0; bj < 2; ++bj) { cs[bj][0] = (f32x4){0.f, 0.f, 0.f, 0.f}; cs[bj][1] = (f32x4){0.f, 0.f, 0.f, 0.f}; }
#pragma unroll
        for (int ai = 0; ai < 2; ++ai)
#pragma unroll
            for (int m = 0; m < 4; ++m) { f16* rowp = base + (size_t)(row0 + ai * HALF + m * 16) * ldc + col0;
#pragma unroll
                for (int bj = 0; bj < 2; ++bj) { const f32x4 v0 = acc[ai][bj][m][0], v1 = acc[ai][bj][m][1];
                    cs[bj][0] += v0; cs[bj][1] += v1;
                    u32x4 w; w.x = pkh(v0[0], v0[1]); w.y = pkh(v0[2], v0[3]); w.z = pkh(v1[0], v1[1]); w.w = pkh(v1[2], v1[3]);
                    *(u32x4*)(rowp + bj * HALF) = w; } }
        if (isk) {
#pragma unroll
            for (int bj = 0; bj < 2; ++bj)
#pragma unroll
                for (int n = 0; n < 2; ++n)
#pragma unroll
                    for (int e = 0; e < 4; ++e) { float s = cs[bj][n][e];
                        s += __shfl_xor(s, 1); s += __shfl_xor(s, 2); s += __shfl_xor(s, 4); s += __shfl_xor(s, 8);
                        if (fr == 0) atomicAdd(kms + (size_t)u.pm * DM + kcol0 + bj * HALF + 4 * n + e, s); }
        }
    }
};
struct EpiResid {
    static constexpr bool PERM = false;
    const float* base; float* out; const float* gate; int ldg;
    __device__ __forceinline__ void operator()(const f32x4 (&acc)[2][2][4][2], const Unit& u, int wr, int wc, int fr, int fq) const {
        const int b = (u.pm * BM) / SEQ; const int col0 = u.pn * BM + wc * 32 + 4 * fq;
        f32x4 gv[2][2];
#pragma unroll
        for (int bj = 0; bj < 2; ++bj)
#pragma unroll
            for (int n = 0; n < 2; ++n) { gv[bj][n] = *(const f32x4*)(gate + (size_t)b * ldg + col0 + bj * HALF + n * 16) + 1.0f; }
#pragma unroll
        for (int ai = 0; ai < 2; ++ai)
#pragma unroll
            for (int m = 0; m < 4; ++m) { const size_t off = (size_t)(u.pm * BM + ai * HALF + wr * 64 + m * 16 + fr) * DM + col0;
#pragma unroll
                for (int bj = 0; bj < 2; ++bj)
#pragma unroll
                    for (int n = 0; n < 2; ++n) { const f32x4 bs = *(const f32x4*)(base + off + bj * HALF + n * 16);
                        *(f32x4*)(out + off + bj * HALF + n * 16) = bs + gv[bj][n] * acc[ai][bj][m][n]; } }
    }
};

struct MoeSched {
    const LAS int* tab; const int* list; int G, c, layer, stage;
    __device__ __forceinline__ bool next(int i, Unit& u) const {
        const int ntile = __builtin_amdgcn_readfirstlane(tab[24]); const long L = (long)i * G + c; if (L >= (long)ntile * 4) return false;
        const int tile = (int)(L >> 2), sub = (int)(L & 3);
        int cls = 0;
#pragma unroll 1
        for (int j = 1; j < NCLS; ++j) cls += (tab[j] <= tile) ? 1 : 0;
        cls = __builtin_amdgcn_readfirstlane(cls);
        u.pm = tile; u.pn = sub; u.cls = cls; u.tin = tile - __builtin_amdgcn_readfirstlane(tab[cls]); return true;
    }
    __device__ __forceinline__ size_t a_off(const Unit& u) const { return (size_t)u.pm * BM * 512 * 2; }
    __device__ __forceinline__ size_t b_off(const Unit& u) const {
        if (stage == 1) { const int g = u.cls / 6, p = u.cls % 6; const int a = p < 3 ? 0 : (p < 5 ? 1 : 2), bb = p < 3 ? p + 1 : (p < 5 ? p - 1 : 3);
            const int e = g * 4 + ((u.pn >> 1) ? bb : a); return ((size_t)(layer * NE + e) * 512 + (size_t)(u.pn & 1) * 256) * DM * 2; }
        return ((size_t)(layer * NCLS + u.cls) * DM + (size_t)u.pn * 256) * 512 * 2;
    }
    __device__ __forceinline__ int row_tok(const Unit& u, int r) const { int idx = u.tin * BM + r; const int cmax = tab[32 + u.cls] - 1; idx = idx < cmax ? idx : cmax; return list[u.cls * MT + idx]; }
};
struct EpiMoe1 {
    static constexpr bool PERM = true;
    f16* hid; const float* cw; MoeSched S;
    __device__ __forceinline__ void operator()(const f32x4 (&acc)[2][2][4][2], const Unit& u, int wr, int wc, int fr, int fq) const {
        const int k = u.pn >> 1, pnc = u.pn & 1; const int col0 = k * 256 + pnc * 128 + wc * 32 + 8 * fq;
#pragma unroll
        for (int ai = 0; ai < 2; ++ai)
#pragma unroll
            for (int m = 0; m < 4; ++m) { const int r = ai * HALF + wr * 64 + m * 16 + fr; const int tok = S.row_tok(u, r); const float cwv = cw[tok * 2 + k];
                float o[8];
#pragma unroll
                for (int n = 0; n < 2; ++n)
#pragma unroll
                    for (int e = 0; e < 4; ++e) { const float gg = acc[ai][0][m][n][e], uu = acc[ai][1][m][n][e];
                        const float sg = gg * __builtin_amdgcn_rcpf(1.f + __builtin_amdgcn_exp2f(-gg * LOG2E)); o[n * 4 + e] = sg * uu * cwv; }
                u32x4 w; w.x = pkh(o[0], o[1]); w.y = pkh(o[2], o[3]); w.z = pkh(o[4], o[5]); w.w = pkh(o[6], o[7]);
                *(u32x4*)(hid + (size_t)(u.pm * BM + r) * 512 + col0) = w; }
    }
};
struct EpiMoe2 {
    static constexpr bool PERM = false;
    float* x; const float* gate; int ldg; MoeSched S;
    __device__ __forceinline__ void operator()(const f32x4 (&acc)[2][2][4][2], const Unit& u, int wr, int wc, int fr, int fq) const {
        const int col0 = u.pn * BM + wc * 32 + 4 * fq; const int cnt = S.tab[32 + u.cls];
#pragma unroll
        for (int ai = 0; ai < 2; ++ai)
#pragma unroll
            for (int m = 0; m < 4; ++m) { const int r = ai * HALF + wr * 64 + m * 16 + fr; const int idx = u.tin * BM + r;
                if (idx < cnt) { const int tok = S.list[u.cls * MT + idx]; const int b = tok / SEQ; float* xr = x + (size_t)tok * DM + col0; const float* gr = gate + (size_t)b * ldg + col0;
#pragma unroll
                    for (int bj = 0; bj < 2; ++bj)
#pragma unroll
                        for (int n = 0; n < 2; ++n) { const f32x4 gv = *(const f32x4*)(gr + bj * HALF + n * 16) + 1.0f; const f32x4 bs = *(const f32x4*)(xr + bj * HALF + n * 16);
                            *(f32x4*)(xr + bj * HALF + n * 16) = bs + gv * acc[ai][bj][m][n]; } } }
    }
};
__device__ __forceinline__ void mod_item(const float* __restrict__ c, const float* __restrict__ W, const float* __restrict__ bias, float* out, int N, int n0, LAS float* red, int tid) {
    const int wave = tid >> 6, lane = tid & 63;
    float a0 = 0.f, a1 = 0.f, a2 = 0.f, a3 = 0.f;
    const float* wp = W + (size_t)(wave * 128) * N + n0 + lane;
    const float* cp = c + wave * 128;
#pragma unroll 16
    for (int k = 0; k < 128; ++k) { const float w = wp[(size_t)k * N]; a0 += cp[k] * w; a1 += cp[DM + k] * w; a2 += cp[2 * DM + k] * w; a3 += cp[3 * DM + k] * w; }
    red[(wave * 4 + 0) * 64 + lane] = a0; red[(wave * 4 + 1) * 64 + lane] = a1; red[(wave * 4 + 2) * 64 + lane] = a2; red[(wave * 4 + 3) * 64 + lane] = a3;
    __syncthreads();
    if (tid < 256) { const int b = tid >> 6, l = tid & 63; float s = bias[n0 + l];
#pragma unroll
        for (int w = 0; w < 8; ++w) s += red[(w * 4 + b) * 64 + l];
        out[(size_t)b * N + n0 + l] = s; }
    __syncthreads();
}
__device__ __forceinline__ void tr_item(const float* __restrict__ src, int ld_src, int k0, int n0, f16* dst, int ld_dst, int drow, int dk, LAS float* scr, int lane) {
#pragma unroll 8
    for (int i = 0; i < 32; ++i) { const int kk = 2 * i + (lane >> 5); scr[kk * 33 + (lane & 31)] = src[(size_t)(k0 + kk) * ld_src + n0 + (lane & 31)]; }
    asm volatile("s_waitcnt lgkmcnt(0)" ::: "memory");
    const int c = lane & 7;
#pragma unroll
    for (int j = 0; j < 4; ++j) { const int n = (lane >> 3) + 8 * j; const LAS float* s = scr + (8 * c) * 33 + n;
        u32x4 o; o.x = pkh(s[0 * 33], s[1 * 33]); o.y = pkh(s[2 * 33], s[3 * 33]); o.z = pkh(s[4 * 33], s[5 * 33]); o.w = pkh(s[6 * 33], s[7 * 33]);
        *(u32x4*)(dst + (size_t)(drow + n) * ld_dst + dk + k0 + 8 * c) = o; }
    asm volatile("s_waitcnt lgkmcnt(0)" ::: "memory");
}
struct Affine { f32x4 a[4], s[4]; };
__device__ __forceinline__ void load_affine(Affine& A, const float* __restrict__ g, const float* sc, const float* sh, int lane) {
#pragma unroll
    for (int j = 0; j < 4; ++j) { const int i = 4 * lane + 256 * j; const f32x4 gv = *(const f32x4*)(g + i), sv = *(const f32x4*)(sc + i); A.a[j] = gv * (sv + 1.0f); A.s[j] = *(const f32x4*)(sh + i); }
}
__device__ __forceinline__ void store_h(f16* orow, const f32x4 (&v)[4], float rs, const Affine& A, int lane) {
#pragma unroll
    for (int j = 0; j < 4; ++j) { const f32x4 h = v[j] * rs * A.a[j] + A.s[j]; u32x2 w; w.x = pkh(h[0], h[1]); w.y = pkh(h[2], h[3]); *(u32x2*)(orow + 4 * lane + 256 * j) = w; }
}
__device__ __forceinline__ float load_row(const float* xrow, f32x4 (&v)[4], int lane) {
    float s = 0.f;
#pragma unroll
    for (int j = 0; j < 4; ++j) { v[j] = *(const f32x4*)(xrow + 4 * lane + 256 * j); s += (v[j][0] * v[j][0] + v[j][1] * v[j][1]) + (v[j][2] * v[j][2] + v[j][3] * v[j][3]); }
    return __builtin_amdgcn_rsqf(wave_sum(s) * (1.f / DM) + EPS);
}

__device__ __forceinline__ void sb_naive_item(int idx, f16* Q, const f16* __restrict__ K, const f16* __restrict__ V) {
    const int t = idx % SEQ, h = (idx / SEQ) % NH, b = idx / (SEQ * NH);
    f16* qp = Q + (size_t)(b * SEQ + t) * DM + h * HD;
    f16 q[HD]; float o[HD];
#pragma unroll
    for (int d = 0; d < HD; ++d) { q[d] = qp[d]; o[d] = 0.f; }
    float R = 0.f;
    for (int s = t - 1; s >= 0; --s) {
        const f16* kp = K + (size_t)(b * SEQ + s) * DM + h * HD;
        float z = 0.f;
#pragma unroll
        for (int d = 0; d < HD; ++d) z += (float)q[d] * (float)kp[d];
        z = fminf(z, 126.f);
        const float L = log2f(1.f + exp2f(z));
        const float Cc = R + L;
        const float w = exp2f(z - Cc);
        const f16* vp = V + (size_t)(b * SEQ + s) * DM + h * HD;
#pragma unroll
        for (int d = 0; d < HD; ++d) o[d] += w * (float)vp[d];
        R = Cc;
        if (R > 152.f) break;
    }
#pragma unroll
    for (int d = 0; d < HD; ++d) qp[d] = (f16)o[d];
}
__device__ __forceinline__ void moba_naive_item(int idx, f16* Q, const f16* __restrict__ K, const f16* __restrict__ V, const float* __restrict__ kms) {
    const int t = idx % SEQ, h = (idx / SEQ) % NH, b = idx / (SEQ * NH);
    f16* qp = Q + (size_t)(b * SEQ + t) * DM + h * HD;
    f16 q[HD]; float o[HD];
#pragma unroll
    for (int d = 0; d < HD; ++d) { q[d] = qp[d]; o[d] = 0.f; }
    const int own = t / MBLK;
    float v0 = -INFINITY, v1 = -INFINITY, v2 = -INFINITY; int i0 = -1, i1 = -1, i2 = -1;
    for (int j = 0; j < own; ++j) {
        const float* kp = kms + (size_t)(b * NBLK + j) * DM + h * HD;
        float gsc = 0.f;
#pragma unroll
        for (int d = 0; d < HD; ++d) gsc += (float)q[d] * kp[d];
        if (gsc > v0) { v2 = v1; i2 = i1; v1 = v0; i1 = i0; v0 = gsc; i0 = j; }
        else if (gsc > v1) { v2 = v1; i2 = i1; v1 = gsc; i1 = j; }
        else if (gsc > v2) { v2 = gsc; i2 = j; }
    }
    const float slope2 = exp2f(-0.5f * (float)(h + 1)) * LOG2E;
    float m = -INFINITY, l = 0.f;
#pragma unroll
    for (int si = 0; si < 4; ++si) {
        const int j = si == 0 ? i0 : si == 1 ? i1 : si == 2 ? i2 : own;
        if (j < 0) continue;
        const int k_lo = j * MBLK, k_hi = (j == own) ? t : (k_lo + MBLK - 1);
        for (int s = k_lo; s <= k_hi; ++s) {
            const f16* kp = K + (size_t)(b * SEQ + s) * DM + h * HD;
            float z = 0.f;
#pragma unroll
            for (int d = 0; d < HD; ++d) z += (float)q[d] * (float)kp[d];
            z = z - slope2 * (float)(t - s);
            const float mn = fmaxf(m, z);
            const float al = exp2f(m - mn), p = exp2f(z - mn);
            l = l * al + p;
            const f16* vp = V + (size_t)(b * SEQ + s) * DM + h * HD;
#pragma unroll
            for (int d = 0; d < HD; ++d) o[d] = o[d] * al + p * (float)vp[d];
            m = mn;
        }
    }
    const float inv = 1.f / l;
#pragma unroll
    for (int d = 0; d < HD; ++d) qp[d] = (f16)(o[d] * inv);
}

constexpr int N_PHASES = 16;
struct Args { const float* in[22]; float* out; unsigned char* ws; int ph_lo, ph_hi, bar_region, pad; };
__global__ void __launch_bounds__(NTHREADS, 2) mk_fwd(Args args) {
    extern __shared__ __attribute__((aligned(16))) unsigned char lds_raw[];
    LAS unsigned char* lds = (LAS unsigned char*)lds_raw;
    volatile LAS unsigned* MISC = (volatile LAS unsigned*)(lds + MISC_OFF);
    const int tid = threadIdx.x, lane = tid & 63, wave = __builtin_amdgcn_readfirstlane(tid >> 6);
    const int G = gridDim.x; const int bx = blockIdx.x; const int vcu = (G % 8 == 0) ? (bx % 8) * (G / 8) + bx / 8 : bx;
    const int gw = vcu * NWAVES + wave, NGW = G * NWAVES;
    unsigned char* ws = args.ws;
    unsigned* ctl = (unsigned*)(ws + WS_CTL);
    const float* x = args.in[0];      const float* c = args.in[1];
    const float* w_ada = args.in[2];  const float* b_ada = args.in[3];
    const float* g_attn = args.in[4]; const float* g_ffn = args.in[5];
    const float* w_qkv_a = args.in[6]; const float* w_o_a = args.in[7];
    const float* w_ada_kv = args.in[8]; const float* b_ada_kv = args.in[9];
    const float* g_kv = args.in[10];  const float* w_kv = args.in[11];
    const float* w_q_b = args.in[12]; const float* w_o_b = args.in[13];
    const float* w_rg = args.in[14];  const float* b_rg = args.in[15];
    const float* w_re = args.in[16];  const float* b_re = args.in[17];
    const float* w_gate = args.in[18]; const float* w_up = args.in[19];
    const float* w_down = args.in[20]; const float* g_final = args.in[21];
    float* out = args.out;
    float* mod = (float*)(ws + WS_MOD); float* modkv = mod + 2 * 4 * 6144;
    int* list = (int*)(ws + WS_LIST); float* cw = (float*)(ws + WS_CW); float* kms = (float*)(ws + WS_KMS);
    f16* Wqkv0 = (f16*)(ws + WS_WQKV0); f16* Wo0 = (f16*)(ws + WS_WO0); f16* Wkv1 = (f16*)(ws + WS_WKV1); f16* Wq1 = (f16*)(ws + WS_WQ1); f16* Wo1 = (f16*)(ws + WS_WO1);
    f16* Wgu = (f16*)(ws + WS_WGU); f16* Wd2 = (f16*)(ws + WS_WD2);
    f16* A1 = (f16*)(ws + WS_A1); f16* A2 = (f16*)(ws + WS_A2); f16* A3 = (f16*)(ws + WS_A3); f16* A4 = (f16*)(ws + WS_A4); f16* A5 = (f16*)(ws + WS_A5); f16* HID = (f16*)(ws + WS_HID);
    int* ccnt = (int*)(ctl + CW_CNT);

    for (int u = tid; u < (LDS_BYTES - LDSCTL_OFF) / 4; u += NTHREADS) ((LAS unsigned*)(lds + LDSCTL_OFF))[u] = 0u;
    __syncthreads();
    const bool use_bar = (args.ph_hi - args.ph_lo) > 1;
    XcdBarrier bar; bar.bar = ctl + CW_BAR + args.bar_region * XCD_BAR_WORDS; bar.x = 0; bar.st = nullptr;
    if (use_bar) bar = xcd_barrier_post(ctl + CW_BAR + args.bar_region * XCD_BAR_WORDS, MISC + 8);
    const int lo = args.ph_lo, hi = args.ph_hi;
#define IN(k) (lo <= (k) && (k) < hi)
#define SEAM(k) do { if (IN(k) && IN((k) + 1)) xcd_barrier(bar); } while (0)

    if (IN(0)) {
        for (int i = gw * 64 + lane; i < NB * NBLK * DM; i += NGW * 64) kms[i] = 0.f;
        {
            LAS float* red = (LAS float*)lds;
            for (int it = vcu; it < 224; it += G) {
                if (it < 96) mod_item(c, w_ada, b_ada, mod, 6144, it * 64, red, tid);
                else if (it < 192) mod_item(c, w_ada + (size_t)DM * 6144, b_ada + 6144, mod + 4 * 6144, 6144, (it - 96) * 64, red, tid);
                else mod_item(c, w_ada_kv, b_ada_kv, modkv, 2048, (it - 192) * 64, red, tid);
            }
        }
        LAS float* scr = (LAS float*)(lds + 16384 + wave * 12288);
        for (int it = gw; it < 24576; it += NGW) {
            if (it < 1536) { tr_item(w_qkv_a, 3072, 64 * (it / 96), 32 * (it % 96), Wqkv0, DM, 32 * (it % 96), 0, scr, lane); continue; }
            if (it < 2048) { const int r = it - 1536; tr_item(w_o_a, DM, 64 * (r / 32), 32 * (r % 32), Wo0, DM, 32 * (r % 32), 0, scr, lane); continue; }
            if (it < 3072) { const int r = it - 2048; tr_item(w_kv, 2048, 64 * (r / 64), 32 * (r % 64), Wkv1, DM, 32 * (r % 64), 0, scr, lane); continue; }
            if (it < 3584) { const int r = it - 3072; tr_item(w_q_b, DM, 64 * (r / 32), 32 * (r % 32), Wq1, DM, 32 * (r % 32), 0, scr, lane); continue; }
            if (it < 4096) { const int r = it - 3584; tr_item(w_o_b, DM, 64 * (r / 32), 32 * (r % 32), Wo1, DM, 32 * (r % 32), 0, scr, lane); continue; }
            if (it < 12288) { const int r = it - 4096, mat = r >> 7, sub = r & 127; const int le = mat >> 1, which = mat & 1, kb = sub >> 3, nb = sub & 7;
                const float* src = (which ? w_up : w_gate) + (size_t)le * DM * EFF; const int n0 = 32 * nb;
                tr_item(src, EFF, 64 * kb, n0, Wgu + (size_t)le * 512 * DM, DM, 256 * (n0 >> 7) + 128 * which + (n0 & 127), 0, scr, lane); continue; }
            { const int r = it - 12288, mat = r >> 7, sub = r & 127; const int lc = mat >> 1, side = mat & 1, kb = sub >> 5, nb = sub & 31;
                const int layer = lc / NCLS, cls = lc % NCLS, gq = cls / 6, p = cls % 6; const int a = p < 3 ? 0 : (p < 5 ? 1 : 2), bb = p < 3 ? p + 1 : (p < 5 ? p - 1 : 3);
                const int e = gq * 4 + (side ? bb : a);
                tr_item(w_down + (size_t)(layer * NE + e) * EFF * DM, DM, 64 * kb, 32 * nb, Wd2 + (size_t)lc * DM * 512, 512, 32 * nb, 256 * side, scr, lane); }
        }
    }
    SEAM(0);
    if (IN(1)) {
        for (int ch = gw; ch < MT / 16; ch += NGW) {
        const int row0 = ch * 16, b = row0 / SEQ; Affine A; load_affine(A, g_attn, mod + (size_t)b * 6144 + 1024, mod + (size_t)b * 6144, lane);
        for (int r = row0; r < row0 + 16; ++r) { f32x4 v[4]; const float rs = load_row(x + (size_t)r * DM, v, lane); store_h(A1 + (size_t)r * DM, v, rs, A, lane); } }
    }
    SEAM(1);
    if (IN(2)) {
        pg8::Gemm g{(const char*)A1, (const char*)Wqkv0, DM, DM, DM}; pg8::StaticOrder S; S.init(MT, 3072, G, bx, DM, DM);
        EpiF16 E{A3, DM, DM, (size_t)(WS_A4 - WS_A3) / 2, DM, QSCALE};
        pg8::gemm_phase<EpiF16, pg8::StaticOrder, true, false>(lds + RING_OFF, g, S, E);
    }
    SEAM(2);
    if (IN(3)) { for (int idx = vcu * NTHREADS + tid; idx < NB * NH * SEQ; idx += G * NTHREADS) sb_naive_item(idx, A3, A4, A5); }
    SEAM(3);
    if (IN(4)) {
        pg8::Gemm g{(const char*)A3, (const char*)Wo0, DM, DM, DM}; pg8::StaticOrder S; S.init(MT, DM, G, bx, DM, DM);
        EpiResid E{x, out, mod + 2048, 6144};
        pg8::gemm_phase<EpiResid, pg8::StaticOrder, true, false>(lds + RING_OFF, g, S, E);
    }
    SEAM(4);
#define ROUTER_PHASE(LAYER) do { \
        LAS float* wl = (LAS float*)lds; \
        const float* wrg = w_rg + (LAYER) * DM * 4; const float* wre = w_re + (LAYER) * DM * 16; \
        for (int idx = tid; idx < DM * 20; idx += NTHREADS) { const int k = idx / 20, o = idx % 20; const int j = k >> 8, rem = k & 255, l = rem >> 2, e = rem & 3; \
            wl[(j * 64 + l) * 84 + e * 20 + o] = o < 4 ? wrg[k * 4 + o] : wre[k * 16 + o - 4]; } \
        __syncthreads(); \
        const float* md = mod + (size_t)(LAYER) * 4 * 6144; \
        for (int ch = gw; ch < MT / 16; ch += NGW) { \
        const int row0 = ch * 16, b = row0 / SEQ; Affine A; load_affine(A, g_ffn + (LAYER) * DM, md + (size_t)b * 6144 + 4096, md + (size_t)b * 6144 + 3072, lane); \
        float brg[4], bre[16]; \
        _Pragma("unroll") for (int i = 0; i < 4; ++i) brg[i] = b_rg[(LAYER) * 4 + i]; \
        _Pragma("unroll") for (int i = 0; i < 16; ++i) bre[i] = b_re[(LAYER) * 16 + i]; \
        int mycls = 0; float mylo = 0.f, myhi = 0.f; \
        for (int rr = 0; rr < 16; ++rr) { const int r = row0 + rr; f32x4 v[4]; const float rs = load_row(out + (size_t)r * DM, v, lane); store_h(A1 + (size_t)r * DM, v, rs, A, lane); \
            float p[20]; _Pragma("unroll") for (int o = 0; o < 20; ++o) p[o] = 0.f; \
            _Pragma("unroll") for (int j = 0; j < 4; ++j) { const f32x4 h = v[j] * rs * A.a[j] + A.s[j]; \
                _Pragma("unroll") for (int e = 0; e < 4; ++e) { const LAS f32x4* wp = (const LAS f32x4*)(wl + (j * 64 + lane) * 84 + e * 20); \
                    _Pragma("unroll") for (int q4 = 0; q4 < 5; ++q4) { const f32x4 wv = wp[q4]; \
                        p[q4 * 4 + 0] += h[e] * wv[0]; p[q4 * 4 + 1] += h[e] * wv[1]; p[q4 * 4 + 2] += h[e] * wv[2]; p[q4 * 4 + 3] += h[e] * wv[3]; } } \
                asm volatile("" ::: "memory"); } \
            _Pragma("unroll") for (int o = 0; o < 20; ++o) p[o] = wave_sum(p[o]); \
            float lg[4]; _Pragma("unroll") for (int i = 0; i < 4; ++i) lg[i] = p[i] + brg[i]; \
            int gs = 0; float mx = lg[0]; \
            _Pragma("unroll") for (int i = 1; i < 4; ++i) if (lg[i] > mx) { mx = lg[i]; gs = i; } \
            float den = 0.f; _Pragma("unroll") for (int i = 0; i < 4; ++i) den += __expf(lg[i] - mx); \
            const float pg = 1.f / den; \
            float le[4]; _Pragma("unroll") for (int i = 0; i < 4; ++i) { le[i] = gs == 0 ? p[4 + i] + bre[i] : gs == 1 ? p[8 + i] + bre[4 + i] : gs == 2 ? p[12 + i] + bre[8 + i] : p[16 + i] + bre[12 + i]; } \
            int a0 = 0; float va = le[0]; \
            _Pragma("unroll") for (int i = 1; i < 4; ++i) if (le[i] > va) { va = le[i]; a0 = i; } \
            int a1 = -1; float vb = -INFINITY; \
            _Pragma("unroll") for (int i = 0; i < 4; ++i) if (i != a0 && le[i] > vb) { vb = le[i]; a1 = i; } \
            const float e1 = __expf(vb - va), dn = 1.f / (1.f + e1); const float c0 = pg * dn, c1 = pg * e1 * dn;     \
            const int ea = a0 < a1 ? a0 : a1, eb = a0 < a1 ? a1 : a0; const float wlo = a0 < a1 ? c0 : c1, whi = a0 < a1 ? c1 : c0; \
            const int cls = gs * 6 + (ea * (7 - ea)) / 2 + (eb - ea - 1); \
            if (lane == rr) { mycls = cls; mylo = wlo; myhi = whi; } } \
        if (lane < 16) { const int tok = row0 + lane; const int slot = atomicAdd(ccnt + (LAYER) * NCLS + mycls, 1); list[mycls * MT + slot] = tok; cw[tok * 2] = mylo; cw[tok * 2 + 1] = myhi; } } \
    } while (0)
#define MOE_TABLE(LAYER) do { \
        LAS int* tab = (LAS int*)(lds + LDSCTL_OFF); \
        if (tid == 0) { int acc_ = 0; for (int j = 0; j < NCLS; ++j) { const int cn = ccnt[(LAYER) * NCLS + j]; tab[j] = acc_; tab[32 + j] = cn; acc_ += (cn + 255) >> 8; } tab[24] = acc_; } \
        __syncthreads(); } while (0)
#define MOE1_PHASE(LAYER) do { MOE_TABLE(LAYER); \
        MoeSched S{(const LAS int*)(lds + LDSCTL_OFF), list, G, bx, (LAYER), 1}; \
        pg8::Gemm g{(const char*)A1, (const char*)Wgu, DM, DM, DM}; EpiMoe1 E{HID, cw, S}; \
        pg8::gemm_phase<EpiMoe1, MoeSched, true, true>(lds + RING_OFF, g, S, E); } while (0)
#define MOE2_PHASE(LAYER) do { MOE_TABLE(LAYER); \
        MoeSched S{(const LAS int*)(lds + LDSCTL_OFF), list, G, bx, (LAYER), 2}; \
        pg8::Gemm g{(const char*)HID, (const char*)Wd2, 512, 512, 512}; EpiMoe2 E{out, mod + (size_t)(LAYER) * 4 * 6144 + 5120, 6144, S}; \
        pg8::gemm_phase<EpiMoe2, MoeSched, true, false>(lds + RING_OFF, g, S, E); } while (0)
    if (IN(5)) { ROUTER_PHASE(0); }
    SEAM(5);
    if (IN(6)) { MOE1_PHASE(0); }
    SEAM(6);
    if (IN(7)) { MOE2_PHASE(0); }
    SEAM(7);
    if (IN(8)) {
        for (int ch = gw; ch < MT / 16; ch += NGW) {
        const int row0 = ch * 16, b = row0 / SEQ; Affine Akv, Aq;
        load_affine(Akv, g_kv, modkv + (size_t)b * 2048 + 1024, modkv + (size_t)b * 2048, lane);
        load_affine(Aq, g_attn + DM, mod + 4 * 6144 + (size_t)b * 6144 + 1024, mod + 4 * 6144 + (size_t)b * 6144, lane);
        for (int r = row0; r < row0 + 16; ++r) { f32x4 v[4]; const float rs = load_row(out + (size_t)r * DM, v, lane);
            store_h(A1 + (size_t)r * DM, v, rs, Akv, lane); store_h(A2 + (size_t)r * DM, v, rs, Aq, lane); } }
    }
    SEAM(8);
    if (IN(9)) {
        { pg8::Gemm g{(const char*)A1, (const char*)Wkv1, DM, DM, DM}; pg8::StaticOrder S; S.init(MT, 2048, G, bx, DM, DM);
          EpiKV1 E{A4, DM, DM, (size_t)(WS_A5 - WS_A4) / 2, kms};
          pg8::gemm_phase<EpiKV1, pg8::StaticOrder, true, false>(lds + RING_OFF, g, S, E); }
        { pg8::Gemm g{(const char*)A2, (const char*)Wq1, DM, DM, DM}; pg8::StaticOrder S; S.init(MT, DM, G, bx, DM, DM);
          EpiF16 E{A3, DM, 0, 0, DM, QSCALE};
          pg8::gemm_phase<EpiF16, pg8::StaticOrder, true, false>(lds + RING_OFF, g, S, E); }
    }
    SEAM(9);
    if (IN(10)) { for (int idx = vcu * NTHREADS + tid; idx < NB * NH * SEQ; idx += G * NTHREADS) moba_naive_item(idx, A3, A4, A5, kms); }
    SEAM(10);
    if (IN(11)) {
        pg8::Gemm g{(const char*)A3, (const char*)Wo1, DM, DM, DM}; pg8::StaticOrder S; S.init(MT, DM, G, bx, DM, DM);
        EpiResid E{out, out, mod + 4 * 6144 + 2048, 6144};
        pg8::gemm_phase<EpiResid, pg8::StaticOrder, true, false>(lds + RING_OFF, g, S, E);
    }
    SEAM(11);
    if (IN(12)) { ROUTER_PHASE(1); }
    SEAM(12);
    if (IN(13)) { MOE1_PHASE(1); }
    SEAM(13);
    if (IN(14)) { MOE2_PHASE(1); }
    SEAM(14);
    if (IN(15)) {
        f32x4 gf[4];
#pragma unroll
        for (int j = 0; j < 4; ++j) gf[j] = *(const f32x4*)(g_final + 4 * lane + 256 * j);
        for (int ch = gw; ch < MT / 16; ch += NGW) { const int row0 = ch * 16;
        for (int r = row0; r < row0 + 16; ++r) { f32x4 v[4]; const float rs = load_row(out + (size_t)r * DM, v, lane);
#pragma unroll
            for (int j = 0; j < 4; ++j) *(f32x4*)(out + (size_t)r * DM + 4 * lane + 256 * j) = v[j] * rs * gf[j]; } }
    }
#undef IN
#undef SEAM
}

extern "C" void kernel_launch(void* const* d_in, const int* in_sizes, int n_in, void* d_out, int out_size, void* d_ws, size_t ws_size, hipStream_t stream) {
    static int grid = 0;
    if (grid == 0) {
        if (n_in != 22 || out_size != MT * DM || ws_size < WS_END) { fprintf(stderr, "kernel_launch: unexpected shapes (n_in %d out %d ws %zu)\n", n_in, out_size, ws_size); grid = -1; return; }
        int dev = 0, cus = 0, per_cu = 0;
        if (hipGetDevice(&dev) != hipSuccess || hipDeviceGetAttribute(&cus, hipDeviceAttributeMultiprocessorCount, dev) != hipSuccess) { grid = -1; return; }
        if (hipFuncSetAttribute((const void*)mk_fwd, hipFuncAttributeMaxDynamicSharedMemorySize, LDS_BYTES) != hipSuccess) { fprintf(stderr, "kernel_launch: hipFuncSetAttribute failed\n"); grid = -1; return; }
        if (hipOccupancyMaxActiveBlocksPerMultiprocessor(&per_cu, (const void*)mk_fwd, NTHREADS, LDS_BYTES) != hipSuccess || per_cu < 1) { fprintf(stderr, "kernel_launch: occupancy query says %d\n", per_cu); }
        (void)hipGetLastError();
        grid = cus;
    }
    if (grid < 0) return;
    (void)hipMemsetAsync((char*)d_ws + WS_CTL, 0, CTL_ZERO_BYTES, stream);
    Args a{};
    for (int i = 0; i < 22; ++i) a.in[i] = (const float*)d_in[i];
    a.out = (float*)d_out; a.ws = (unsigned char*)d_ws;
    f16* A3 = (f16*)((char*)d_ws + WS_A3); f16* A4 = (f16*)((char*)d_ws + WS_A4); f16* A5 = (f16*)((char*)d_ws + WS_A5); float* kms = (float*)((char*)d_ws + WS_KMS);
#ifndef MK_FUSE
#define MK_FUSE 1
#endif
    int region = 0;
    auto run = [&](int lo, int hi) {
        if (MK_FUSE) { a.ph_lo = lo; a.ph_hi = hi; a.bar_region = region++; hipLaunchKernelGGL(mk_fwd, dim3(grid), dim3(NTHREADS), LDS_BYTES, stream, a); }
        else for (int p = lo; p < hi; ++p) { a.ph_lo = p; a.ph_hi = p + 1; a.bar_region = 0; hipLaunchKernelGGL(mk_fwd, dim3(grid), dim3(NTHREADS), LDS_BYTES, stream, a); }
    };
    run(0, N_PHASES);
}
```

```cpp
#include <hip/hip_runtime.h>
#include <cstdio>
#include <cstdint>

#define GAS __attribute__((address_space(1)))
#define LAS __attribute__((address_space(3)))
typedef _Float16 f16;
typedef _Float16 f16x2 __attribute__((ext_vector_type(2)));
typedef _Float16 f16x4 __attribute__((ext_vector_type(4)));
typedef _Float16 f16x8 __attribute__((ext_vector_type(8)));
typedef float f32x2 __attribute__((ext_vector_type(2)));
typedef float f32x4 __attribute__((ext_vector_type(4)));
typedef float f32x16 __attribute__((ext_vector_type(16)));
typedef unsigned u32x2 __attribute__((ext_vector_type(2)));
typedef unsigned u32x4 __attribute__((ext_vector_type(4)));

constexpr int NB = 4, SEQ = 8192, DM = 1024, MT = NB * SEQ, NH = 16, HD = 64;
constexpr int NBLK = 32, MBLK = 256, NE = 16, EFF = 256, NCLS = 24;
constexpr float EPS = 1e-6f;
constexpr float LOG2E = 1.4426950408889634f;
constexpr float QSCALE = 0.125f * LOG2E;
constexpr int NWAVES = 8, NTHREADS = 512;

__device__ __forceinline__ unsigned pkh(float lo, float hi) { f32x2 v = {lo, hi}; f16x2 h = __builtin_convertvector(v, f16x2); return __builtin_bit_cast(unsigned, h); }
typedef __bf16 bf16x2_t __attribute__((ext_vector_type(2)));
__device__ __forceinline__ unsigned pkb(float lo, float hi) { f32x2 v = {lo, hi}; bf16x2_t h = __builtin_convertvector(v, bf16x2_t); return __builtin_bit_cast(unsigned, h); }
__device__ __forceinline__ float wave_sum(float v) {
#pragma unroll
    for (int o = 1; o < 64; o <<= 1) v += __shfl_xor(v, o);
    return v;
}

namespace pg8 {
constexpr int BM = 256, BK = 64, HALF = 128, HTB = HALF * BK * 2, STAGE_BYTES = 8 * HTB, NXCD = 8, WGM = 8;
__host__ __device__ __forceinline__ int lds_byte(int r, int c) { const int st = (r >> 4) * 2 + (c >> 5), rr = r & 15, cc = c & 31, ob = rr * 64 + cc * 2; return st * 1024 + (ob ^ (((ob >> 9) & 1) << 5)); }
__host__ __device__ __forceinline__ void stage_rc(int b, int& R, int& C) { const int st = b / 1024, sb = b % 1024, swz = sb ^ (((sb >> 9) & 1) << 5); R = (st >> 1) * 16 + swz / 64; C = (st & 1) * 32 + (swz % 64) / 2; }
__host__ __device__ __forceinline__ int perm32(int rho) { const int n = rho >> 4, i = rho & 15; return 8 * (i >> 2) + 4 * n + (i & 3); }

struct Unit { int pm, pn, cls, tin; };
struct Gemm { const char* A; const char* Bt; int K, lda, ldb; };

struct StaticOrder {
    int nM, nN, nwg, G, c, lda2, ldb2;
    __device__ __forceinline__ void init(int M, int N, int G_, int c_, int lda, int ldb) { nM = M / BM; nN = N / BM; nwg = nM * nN; G = G_; c = c_; lda2 = lda * 2; ldb2 = ldb * 2; }
    __device__ __forceinline__ bool next(int i, Unit& u) const {
        const long L = (long)i * G + c; if (L >= nwg) return false;
        int wgid = (int)L; { const int q = nwg / NXCD, r = nwg % NXCD, xcd = wgid % NXCD, off = wgid / NXCD; wgid = (xcd < r ? xcd * (q + 1) : r * (q + 1) + (xcd - r) * q) + off; }
        const int nig = WGM * nN, gid = wgid / nig, fm = gid * WGM, gsz = (nM - fm) < WGM ? (nM - fm) : WGM;
        u.pm = fm + ((wgid % nig) % gsz); u.pn = (wgid % nig) / gsz; u.cls = 0; u.tin = 0; return true;
    }
    __device__ __forceinline__ size_t a_off(const Unit& u) const { return (size_t)u.pm * BM * lda2; }
    __device__ __forceinline__ size_t b_off(const Unit& u) const { return (size_t)u.pn * BM * ldb2; }
    __device__ __forceinline__ int row_tok(const Unit&, int) const { return 0; }
};

template <class Epi, class Sched, bool ALIGN_EPI, bool GATHER>
__device__ __forceinline__ void gemm_phase(LAS unsigned char* lds, const Gemm g, const Sched& S, const Epi& E) {
    const int tid = threadIdx.x, wid = __builtin_amdgcn_readfirstlane(tid >> 6), lane = tid & 63, wr = wid >> 2, wc = wid & 3, fr = lane & 15, fq = lane >> 4;
    const int K = g.K, nt = K / BK;
    int Rr[2], Cc[2];
    unsigned cva0[2], cva1[2], nva0[2], nva1[2], voffB[2];
#pragma unroll
    for (int i = 0; i < 2; ++i) { int R, C; stage_rc(tid * 16 + i * 8192, R, C); Rr[i] = R; Cc[i] = C; const int Rb = Epi::PERM ? ((R & ~31) + perm32(R & 31)) : R;
        cva0[i] = (unsigned)(R * g.lda + C) * 2u; cva1[i] = (unsigned)((R + HALF) * g.lda + C) * 2u; nva0[i] = cva0[i]; nva1[i] = cva1[i];
        voffB[i] = (unsigned)(Rb * g.ldb + C) * 2u; }
    const size_t kstep = (size_t)(BK * 2);
    const size_t hstepB = (size_t)HALF * g.ldb * 2;
    const unsigned ldsw = (unsigned)wid * 1024u;
    const int aoff = lds_byte(wr * 64 + fr, fq * 8), boff = lds_byte(wc * 32 + fr, fq * 8);
#define PG8_SA(b, h) (((b) * 2 + (h)) * HTB)
#define PG8_SB(b, h) ((4 + (b) * 2 + (h)) * HTB)
#define PG8_STAGE(bufoff, gbase, voff) do { _Pragma("unroll") for (int _i = 0; _i < 2; ++_i) \
        __builtin_amdgcn_global_load_lds((const unsigned*)((const char*)(gbase) + (voff)[_i]), (LAS unsigned*)(lds + (bufoff) + ldsw + _i * 8192), 16, 0, 0); } while (0)
#define PG8_LDA(dst, b, h) do { _Pragma("unroll") for (int m = 0; m < 4; ++m) _Pragma("unroll") for (int k = 0; k < 2; ++k) dst[m][k] = *(const LAS f16x8*)(lds + PG8_SA(b, h) + aoff + m * 2048 + k * 1024); } while (0)
#define PG8_LDB(dst, b, h) do { _Pragma("unroll") for (int n = 0; n < 2; ++n) _Pragma("unroll") for (int k = 0; k < 2; ++k) dst[n][k] = *(const LAS f16x8*)(lds + PG8_SB(b, h) + boff + n * 2048 + k * 1024); } while (0)
#define PG8_MMA(ai, bj, At, Bt) do { __builtin_amdgcn_s_setprio(1); _Pragma("unroll") for (int m = 0; m < 4; ++m) _Pragma("unroll") for (int n = 0; n < 2; ++n) _Pragma("unroll") for (int k = 0; k < 2; ++k) \
        acc[ai][bj][m][n] = __builtin_amdgcn_mfma_f32_16x16x32_f16(Bt[n][k], At[m][k], acc[ai][bj][m][n], 0, 0, 0); __builtin_amdgcn_s_setprio(0); } while (0)
#define PG8_WAIT_V(n) asm volatile("s_waitcnt vmcnt(" #n ")" ::: "memory")
#define PG8_WAIT_L(n) asm volatile("s_waitcnt lgkmcnt(" #n ")" ::: "memory")
#define PG8_BAR __builtin_amdgcn_s_barrier()
#define PG8_SCHED __builtin_amdgcn_sched_barrier(0)
#define PG8_GATHER_V(dst0, dst1, U) do { _Pragma("unroll") for (int _i = 0; _i < 2; ++_i) { \
        dst0[_i] = (unsigned)(S.row_tok(U, Rr[_i]) * g.lda + Cc[_i]) * 2u; dst1[_i] = (unsigned)(S.row_tok(U, Rr[_i] + HALF) * g.lda + Cc[_i]) * 2u; } } while (0)
    Unit cur, nxt; int ui = 0;
    if (!S.next(0, cur)) return;
    f32x4 acc[2][2][4][2];
#pragma unroll
    for (int a = 0; a < 2; ++a)
#pragma unroll
        for (int b = 0; b < 2; ++b)
#pragma unroll
            for (int m = 0; m < 4; ++m)
#pragma unroll
                for (int n = 0; n < 2; ++n) acc[a][b][m][n] = (f32x4){0.f, 0.f, 0.f, 0.f};
    f16x8 At[4][2], B0[2][2], B1[2][2];
    if constexpr (GATHER) { PG8_GATHER_V(cva0, cva1, cur); }
    const char* cA = g.A + (GATHER ? (size_t)0 : S.a_off(cur)); const char* cB = g.Bt + S.b_off(cur);
    PG8_STAGE(PG8_SB(0, 0), cB, voffB); PG8_STAGE(PG8_SB(0, 1), cB + hstepB, voffB); PG8_STAGE(PG8_SA(0, 0), cA, cva0); PG8_STAGE(PG8_SA(0, 1), cA, cva1);
    if (wr == 1) PG8_BAR;
    PG8_WAIT_V(2); PG8_BAR;
    PG8_STAGE(PG8_SB(1, 0), cB + kstep, voffB); PG8_STAGE(PG8_SA(1, 0), cA + kstep, cva0); PG8_STAGE(PG8_SB(1, 1), cB + hstepB + kstep, voffB);
    PG8_WAIT_V(6); PG8_BAR;
    for (;;) {
        const bool has_next = S.next(ui + 1, nxt);
        const char* nA = has_next ? g.A + (GATHER ? (size_t)0 : S.a_off(nxt)) : cA; const char* nB = has_next ? g.Bt + S.b_off(nxt) : cB;
        if constexpr (GATHER) { if (has_next) { PG8_GATHER_V(nva0, nva1, nxt); } else {
#pragma unroll
            for (int i = 0; i < 2; ++i) { nva0[i] = cva0[i]; nva1[i] = cva1[i]; } } }
        for (int t = 0; t < nt; t += 2) {
            const bool last = (t == nt - 2);
            const char* a1 = cA + (size_t)(t + 1) * kstep;
            const char* a2 = last ? nA : cA + (size_t)(t + 2) * kstep; const char* b2 = last ? nB : cB + (size_t)(t + 2) * kstep;
            const char* a3 = a2 + kstep; const char* b3 = b2 + kstep;
            unsigned w0[2], w1[2];
#pragma unroll
            for (int i = 0; i < 2; ++i) { w0[i] = (GATHER && last) ? nva0[i] : cva0[i]; w1[i] = (GATHER && last) ? nva1[i] : cva1[i]; }
            PG8_LDB(B0, 0, 0); PG8_LDB(B1, 0, 1); PG8_SCHED; PG8_LDA(At, 0, 0); PG8_STAGE(PG8_SA(1, 1), a1, cva1);
            PG8_WAIT_V(8); PG8_WAIT_L(0); PG8_BAR; PG8_MMA(0, 0, At, B0); PG8_MMA(0, 1, At, B1); PG8_BAR; PG8_SCHED;
            PG8_LDA(At, 0, 1); PG8_STAGE(PG8_SB(0, 0), b2, voffB); PG8_STAGE(PG8_SB(0, 1), b2 + hstepB, voffB); PG8_STAGE(PG8_SA(0, 0), a2, w0);
            PG8_WAIT_V(8); PG8_WAIT_L(0); PG8_BAR; PG8_MMA(1, 0, At, B0); PG8_MMA(1, 1, At, B1); PG8_BAR; PG8_SCHED;
            PG8_LDB(B0, 1, 0); PG8_LDB(B1, 1, 1); PG8_SCHED; PG8_LDA(At, 1, 0); PG8_STAGE(PG8_SA(0, 1), a2, w1);
            PG8_WAIT_V(8); PG8_WAIT_L(0); PG8_BAR; PG8_MMA(0, 0, At, B0); PG8_MMA(0, 1, At, B1); PG8_BAR; PG8_SCHED;
            PG8_LDA(At, 1, 1); PG8_STAGE(PG8_SB(1, 0), b3, voffB); PG8_STAGE(PG8_SB(1, 1), b3 + hstepB, voffB); PG8_STAGE(PG8_SA(1, 0), a3, w0);
            PG8_WAIT_V(8); PG8_WAIT_L(0); PG8_BAR; PG8_MMA(1, 0, At, B0); PG8_MMA(1, 1, At, B1); PG8_BAR; PG8_SCHED;
        }
        if constexpr (ALIGN_EPI) { if (wr == 0) PG8_BAR; }
        E(acc, cur, wr, wc, fr, fq);
        if (!has_next) break;
#pragma unroll
        for (int a = 0; a < 2; ++a)
#pragma unroll
            for (int b = 0; b < 2; ++b)
#pragma unroll
                for (int m = 0; m < 4; ++m)
#pragma unroll
                    for (int n = 0; n < 2; ++n) acc[a][b][m][n] = (f32x4){0.f, 0.f, 0.f, 0.f};
        cur = nxt; cA = nA; cB = nB; ++ui;
        if constexpr (GATHER) {
#pragma unroll
            for (int i = 0; i < 2; ++i) { cva0[i] = nva0[i]; cva1[i] = nva1[i]; } }
        if constexpr (ALIGN_EPI) { if (wr == 1) PG8_BAR; }
    }
    PG8_WAIT_V(0);
    if constexpr (!ALIGN_EPI) { if (wr == 0) PG8_BAR; }
    PG8_BAR;
#undef PG8_SA
#undef PG8_SB
#undef PG8_STAGE
#undef PG8_LDA
#undef PG8_LDB
#undef PG8_MMA
#undef PG8_WAIT_V
#undef PG8_WAIT_L
#undef PG8_BAR
#undef PG8_SCHED
#undef PG8_GATHER_V
}
}
constexpr size_t MiB = 1u << 20;
constexpr size_t WS_CTL = 0, CTL_ZERO_BYTES = 1 * MiB;
constexpr size_t WS_MOD = 1 * MiB;
constexpr size_t WS_LIST = 2 * MiB;
constexpr size_t WS_CW = 5 * MiB;
constexpr size_t WS_KMS = 6 * MiB;
constexpr size_t WS_WQKV0 = 8 * MiB, WS_WO0 = 14 * MiB, WS_WKV1 = 16 * MiB, WS_WQ1 = 20 * MiB, WS_WO1 = 22 * MiB;
constexpr size_t WS_WGU = 24 * MiB;
constexpr size_t WS_WD2 = 56 * MiB;
constexpr size_t WS_A1 = 104 * MiB, WS_A2 = 168 * MiB, WS_A3 = 232 * MiB, WS_A4 = 296 * MiB, WS_A5 = 360 * MiB;
constexpr size_t WS_HID = 424 * MiB;
constexpr size_t WS_END = 464 * MiB;
constexpr int CW_BAR = 4096;
constexpr int CW_CNT = 64;

constexpr int RING_OFF = 0, RING_BYTES = 131072;
constexpr int LDSCTL_OFF = RING_BYTES, MISC_OFF = LDSCTL_OFF + 320;
constexpr int LDS_BYTES = 147456;

#define XB_TMO      128
#define XB_XCNT(j)  (256  + 64 * (j))
#define XB_XSUB(j)  (1280 + 64 * (j))
#define XB_XGEN(j)  (2304 + 64 * (j))
#define XB_TOP      3328
#define XB_TOPGEN   3392
#define XCD_BAR_WORDS 3456
#define XB_SPIN_CAP (1u << 18)
__device__ __forceinline__ unsigned xb_ld(unsigned* p)              { return __hip_atomic_load(p, __ATOMIC_RELAXED, __HIP_MEMORY_SCOPE_AGENT); }
__device__ __forceinline__ unsigned xb_add(unsigned* p, unsigned v) { return __hip_atomic_fetch_add(p, v, __ATOMIC_RELAXED, __HIP_MEMORY_SCOPE_AGENT); }
__device__ __forceinline__ unsigned xb_xcc_id() { return (unsigned)__builtin_amdgcn_s_getreg((3 << 11) | 20) & 0xFu; }
#define XB_SPIN(cond, bar) do { unsigned _sp = 0; while (cond) { __builtin_amdgcn_s_sleep(1); \
    if ((++_sp & 255u) == 0u) { if (xb_ld(&(bar)[XB_TMO])) break; if (_sp > XB_SPIN_CAP) { atomicAdd(&(bar)[XB_TMO], 1u); break; } } } } while (0)
struct XcdBarrier { unsigned* bar; unsigned x; volatile LAS unsigned* st; };
__device__ __forceinline__ XcdBarrier xcd_barrier_post(unsigned* bar, volatile LAS unsigned* st) {
    XcdBarrier b; b.bar = bar; b.x = xb_xcc_id(); b.st = st;
    if (threadIdx.x == 0) (void)xb_add(&bar[XB_XCNT(b.x)], 1u);
    return b;
}
__device__ __forceinline__ void xcd_barrier_complete(unsigned* bar, unsigned x, unsigned& nloc, unsigned& nx) {
    const unsigned G = gridDim.x * gridDim.y * gridDim.z;
    unsigned sum, cnt, mine, sp = 0u;
    for (;;) {
        sum = 0u; cnt = 0u; mine = 0u;
#pragma unroll
        for (unsigned j = 0; j < 16; ++j) { const unsigned c = xb_ld(&bar[XB_XCNT(j)]); sum += c; cnt += (c > 0u) ? 1u : 0u; mine = (j == x) ? c : mine; }
        if (sum == G) break;
        __builtin_amdgcn_s_sleep(1);
        if ((++sp & 255u) == 0u) { if (xb_ld(&bar[XB_TMO])) break; if (sp > XB_SPIN_CAP) { atomicAdd(&bar[XB_TMO], 1u); break; } }
    }
    nloc = mine > 0u ? mine : 1u; nx = cnt > 0u ? cnt : 1u;
}
__device__ __forceinline__ void xcd_barrier(const XcdBarrier& b) {
    asm volatile("s_waitcnt vmcnt(0)" ::: "memory");
    __syncthreads();
    if (threadIdx.x == 0) {
        unsigned* bar = b.bar;
        __builtin_amdgcn_s_waitcnt(0);
        unsigned nloc = b.st[0], nx = b.st[1];
        if (nloc == 0u) { xcd_barrier_complete(bar, b.x, nloc, nx); b.st[0] = nloc; b.st[1] = nx; }
        const unsigned old = xb_add(&bar[XB_XSUB(b.x)], 1u);
        const unsigned gen = old / nloc;
        if (old + 1u == (gen + 1u) * nloc) {
            __builtin_amdgcn_fence(__ATOMIC_RELEASE, "agent");
            asm volatile("s_waitcnt vmcnt(0)" ::: "memory");
            const unsigned og = xb_add(&bar[XB_TOP], 1u);
            const unsigned tg = og / nx;
            if (og + 1u == (tg + 1u) * nx) xb_add(&bar[XB_TOPGEN], 1u);
            else XB_SPIN(xb_ld(&bar[XB_TOPGEN]) == tg, bar);
            __builtin_amdgcn_fence(__ATOMIC_ACQUIRE, "agent");
            xb_add(&bar[XB_XGEN(b.x)], 1u);
            asm volatile("s_waitcnt vmcnt(0)" ::: "memory");
        } else {
            XB_SPIN(xb_ld(&bar[XB_XGEN(b.x)]) == gen, bar);
            __builtin_amdgcn_fence(__ATOMIC_ACQUIRE, "agent");
            asm volatile("s_waitcnt vmcnt(0)" ::: "memory");
        }
    }
    __syncthreads();
}

using pg8::Unit; using pg8::BM; using pg8::HALF;
struct EpiF16 {
    static constexpr bool PERM = true;
    f16* O; int ldc; int split_cols; size_t split_stride; int qcols; float qscale; int obf;
    __device__ __forceinline__ void operator()(const f32x4 (&acc)[2][2][4][2], const Unit& u, int wr, int wc, int fr, int fq) const {
        const int row0 = u.pm * BM + wr * 64 + fr; int colt = u.pn * BM; f16* base = O;
        const float sc = (colt < qcols) ? qscale : 1.f;
        if (split_cols) { const int t = colt / split_cols; base += (size_t)t * split_stride; colt -= t * split_cols; }
        const int col0 = colt + wc * 32 + 8 * fq;
#pragma unroll
        for (int ai = 0; ai < 2; ++ai)
#pragma unroll
            for (int m = 0; m < 4; ++m) { f16* rowp = base + (size_t)(row0 + ai * HALF + m * 16) * ldc + col0;
#pragma unroll
                for (int bj = 0; bj < 2; ++bj) { const f32x4 v0 = acc[ai][bj][m][0] * sc, v1 = acc[ai][bj][m][1] * sc;
                    u32x4 w; if (obf) { w.x = pkb(v0[0], v0[1]); w.y = pkb(v0[2], v0[3]); w.z = pkb(v1[0], v1[1]); w.w = pkb(v1[2], v1[3]); }
                    else { w.x = pkh(v0[0], v0[1]); w.y = pkh(v0[2], v0[3]); w.z = pkh(v1[0], v1[1]); w.w = pkh(v1[2], v1[3]); }
                    *(u32x4*)(rowp + bj * HALF) = w; } }
    }
};
struct EpiKV1 {
    static constexpr bool PERM = true;
    f16* O; int ldc; int split_cols; size_t split_stride; float* kms;
    __device__ __forceinline__ void operator()(const f32x4 (&acc)[2][2][4][2], const Unit& u, int wr, int wc, int fr, int fq) const {
        const int row0 = u.pm * BM + wr * 64 + fr; int colt = u.pn * BM; f16* base = O;
        const bool isk = colt < DM; const int kcol0 = colt + wc * 32 + 8 * fq;
        if (split_cols) { const int t = colt / split_cols; base += (size_t)t * split_stride; colt -= t * split_cols; }
        const int col0 = colt + wc * 32 + 8 * fq;
        f32x4 cs[2][2];
#pragma unroll
        for (int bj = 0; bj < 2; ++bj) { cs[bj][0] = (f32x4){0.f, 0.f, 0.f, 0.f}; cs[bj][1] = (f32x4){0.f, 0.f, 0.f, 0.f}; }
#pragma unroll
        for (int ai = 0; ai < 2; ++ai)
#pragma unroll
            for (int m = 0; m < 4; ++m) { f16* rowp = base + (size_t)(row0 + ai * HALF + m * 16) * ldc + col0;
#pragma unroll
                for (int bj = 0; bj < 2; ++bj) { const f32x4 v0 = acc[ai][bj][m][0], v1 = acc[ai][bj][m][1];
                    cs[bj][0] += v0; cs[bj][1] += v1;
                    u32x4 w; w.x = pkh(v0[0], v0[1]); w.y = pkh(v0[2], v0[3]); w.z = pkh(v1[0], v1[1]); w.w = pkh(v1[2], v1[3]);
                    *(u32x4*)(rowp + bj * HALF) = w; } }
        if (isk) {
#pragma unroll
            for (int bj = 0; bj < 2; ++bj)
#pragma unroll
                for (int n = 0; n < 2; ++n)
#pragma unroll
                    for (int e = 0; e < 4; ++e) { float s = cs[bj][n][e];
                        s += __shfl_xor(s, 1); s += __shfl_xor(s, 2); s += __shfl_xor(s, 4); s += __shfl_xor(s, 8);
                        if (fr == 0) atomicAdd(kms + (size_t)u.pm * DM + kcol0 + bj * HALF + 4 * n + e, s); }
        }
    }
};
struct EpiResid {
    static constexpr bool PERM = false;
    const float* base; float* out; const float* gate; int ldg;
    __device__ __forceinline__ void operator()(const f32x4 (&acc)[2][2][4][2], const Unit& u, int wr, int wc, int fr, int fq) const {
        const int b = (u.pm * BM) / SEQ; const int col0 = u.pn * BM + wc * 32 + 4 * fq;
        f32x4 gv[2][2];
#pragma unroll
        for (int bj = 0; bj < 2; ++bj)
#pragma unroll
            for (int n = 0; n < 2; ++n) { gv[bj][n] = *(const f32x4*)(gate + (size_t)b * ldg + col0 + bj * HALF + n * 16) + 1.0f; }
#pragma unroll
        for (int ai = 0; ai < 2; ++ai)
#pragma unroll
            for (int m = 0; m < 4; ++m) { const size_t off = (size_t)(u.pm * BM + ai * HALF + wr * 64 + m * 16 + fr) * DM + col0;
#pragma unroll
                for (int bj = 0; bj < 2; ++bj)
#pragma unroll
                    for (int n = 0; n < 2; ++n) { const f32x4 bs = *(const f32x4*)(base + off + bj * HALF + n * 16);
                        *(f32x4*)(out + off + bj * HALF + n * 16) = bs + gv[bj][n] * acc[ai][bj][m][n]; } }
    }
};

struct MoeSched {
    const LAS int* tab; const int* list; int G, c, layer, stage;
    __device__ __forceinline__ bool next(int i, Unit& u) const {
        const int ntile = __builtin_amdgcn_readfirstlane(tab[24]); const long L = (long)i * G + c; if (L >= (long)ntile * 4) return false;
        const int tile = (int)(L >> 2), sub = (int)(L & 3);
        int cls = 0;
#pragma unroll 1
        for (int j = 1; j < NCLS; ++j) cls += (tab[j] <= tile) ? 1 : 0;
        cls = __builtin_amdgcn_readfirstlane(cls);
        u.pm = tile; u.pn = sub; u.cls = cls; u.tin = tile - __builtin_amdgcn_readfirstlane(tab[cls]); return true;
    }
    __device__ __forceinline__ size_t a_off(const Unit& u) const { return (size_t)u.pm * BM * 512 * 2; }
    __device__ __forceinline__ size_t b_off(const Unit& u) const {
        if (stage == 1) { const int g = u.cls / 6, p = u.cls % 6; const int a = p < 3 ? 0 : (p < 5 ? 1 : 2), bb = p < 3 ? p + 1 : (p < 5 ? p - 1 : 3);
            const int e = g * 4 + ((u.pn >> 1) ? bb : a); return ((size_t)(layer * NE + e) * 512 + (size_t)(u.pn & 1) * 256) * DM * 2; }
        return ((size_t)(layer * NCLS + u.cls) * DM + (size_t)u.pn * 256) * 512 * 2;
    }
    __device__ __forceinline__ int row_tok(const Unit& u, int r) const { int idx = u.tin * BM + r; const int cmax = tab[32 + u.cls] - 1; idx = idx < cmax ? idx : cmax; return list[u.cls * MT + idx]; }
};
struct EpiMoe1 {
    static constexpr bool PERM = true;
    f16* hid; const float* cw; MoeSched S;
    __device__ __forceinline__ void operator()(const f32x4 (&acc)[2][2][4][2], const Unit& u, int wr, int wc, int fr, int fq) const {
        const int k = u.pn >> 1, pnc = u.pn & 1; const int col0 = k * 256 + pnc * 128 + wc * 32 + 8 * fq;
#pragma unroll
        for (int ai = 0; ai < 2; ++ai)
#pragma unroll
            for (int m = 0; m < 4; ++m) { const int r = ai * HALF + wr * 64 + m * 16 + fr; const int tok = S.row_tok(u, r); const float cwv = cw[tok * 2 + k];
                float o[8];
#pragma unroll
                for (int n = 0; n < 2; ++n)
#pragma unroll
                    for (int e = 0; e < 4; ++e) { const float gg = acc[ai][0][m][n][e], uu = acc[ai][1][m][n][e];
                        const float sg = gg * __builtin_amdgcn_rcpf(1.f + __builtin_amdgcn_exp2f(-gg * LOG2E)); o[n * 4 + e] = sg * uu * cwv; }
                u32x4 w; w.x = pkh(o[0], o[1]); w.y = pkh(o[2], o[3]); w.z = pkh(o[4], o[5]); w.w = pkh(o[6], o[7]);
                *(u32x4*)(hid + (size_t)(u.pm * BM + r) * 512 + col0) = w; }
    }
};
struct EpiMoe2 {
    static constexpr bool PERM = false;
    float* x; const float* gate; int ldg; MoeSched S;
    __device__ __forceinline__ void operator()(const f32x4 (&acc)[2][2][4][2], const Unit& u, int wr, int wc, int fr, int fq) const {
        const int col0 = u.pn * BM + wc * 32 + 4 * fq; const int cnt = S.tab[32 + u.cls];
#pragma unroll
        for (int ai = 0; ai < 2; ++ai)
#pragma unroll
            for (int m = 0; m < 4; ++m) { const int r = ai * HALF + wr * 64 + m * 16 + fr; const int idx = u.tin * BM + r;
                if (idx < cnt) { const int tok = S.list[u.cls * MT + idx]; const int b = tok / SEQ; float* xr = x + (size_t)tok * DM + col0; const float* gr = gate + (size_t)b * ldg + col0;
#pragma unroll
                    for (int bj = 0; bj < 2; ++bj)
#pragma unroll
                        for (int n = 0; n < 2; ++n) { const f32x4 gv = *(const f32x4*)(gr + bj * HALF + n * 16) + 1.0f; const f32x4 bs = *(const f32x4*)(xr + bj * HALF + n * 16);
                            *(f32x4*)(xr + bj * HALF + n * 16) = bs + gv * acc[ai][bj][m][n]; } } }
    }
};
__device__ __forceinline__ void mod_item(const float* __restrict__ c, const float* __restrict__ W, const float* __restrict__ bias, float* out, int N, int n0, LAS float* red, int tid) {
    const int wave = tid >> 6, lane = tid & 63;
    float a0 = 0.f, a1 = 0.f, a2 = 0.f, a3 = 0.f;
    const float* wp = W + (size_t)(wave * 128) * N + n0 + lane;
    const float* cp = c + wave * 128;
#pragma unroll 16
    for (int k = 0; k < 128; ++k) { const float w = wp[(size_t)k * N]; a0 += cp[k] * w; a1 += cp[DM + k] * w; a2 += cp[2 * DM + k] * w; a3 += cp[3 * DM + k] * w; }
    red[(wave * 4 + 0) * 64 + lane] = a0; red[(wave * 4 + 1) * 64 + lane] = a1; red[(wave * 4 + 2) * 64 + lane] = a2; red[(wave * 4 + 3) * 64 + lane] = a3;
    __syncthreads();
    if (tid < 256) { const int b = tid >> 6, l = tid & 63; float s = bias[n0 + l];
#pragma unroll
        for (int w = 0; w < 8; ++w) s += red[(w * 4 + b) * 64 + l];
        out[(size_t)b * N + n0 + l] = s; }
    __syncthreads();
}
__device__ __forceinline__ void tr_item(const float* __restrict__ src, int ld_src, int k0, int n0, f16* dst, int ld_dst, int drow, int dk, LAS float* scr, int lane) {
#pragma unroll 8
    for (int i = 0; i < 32; ++i) { const int kk = 2 * i + (lane >> 5); scr[kk * 33 + (lane & 31)] = src[(size_t)(k0 + kk) * ld_src + n0 + (lane & 31)]; }
    asm volatile("s_waitcnt lgkmcnt(0)" ::: "memory");
    const int c = lane & 7;
#pragma unroll
    for (int j = 0; j < 4; ++j) { const int n = (lane >> 3) + 8 * j; const LAS float* s = scr + (8 * c) * 33 + n;
        u32x4 o; o.x = pkh(s[0 * 33], s[1 * 33]); o.y = pkh(s[2 * 33], s[3 * 33]); o.z = pkh(s[4 * 33], s[5 * 33]); o.w = pkh(s[6 * 33], s[7 * 33]);
        *(u32x4*)(dst + (size_t)(drow + n) * ld_dst + dk + k0 + 8 * c) = o; }
    asm volatile("s_waitcnt lgkmcnt(0)" ::: "memory");
}
struct Affine { f32x4 a[4], s[4]; };
__device__ __forceinline__ void load_affine(Affine& A, const float* __restrict__ g, const float* sc, const float* sh, int lane) {
#pragma unroll
    for (int j = 0; j < 4; ++j) { const int i = 4 * lane + 256 * j; const f32x4 gv = *(const f32x4*)(g + i), sv = *(const f32x4*)(sc + i); A.a[j] = gv * (sv + 1.0f); A.s[j] = *(const f32x4*)(sh + i); }
}
__device__ __forceinline__ void store_h(f16* orow, const f32x4 (&v)[4], float rs, const Affine& A, int lane) {
#pragma unroll
    for (int j = 0; j < 4; ++j) { const f32x4 h = v[j] * rs * A.a[j] + A.s[j]; u32x2 w; w.x = pkh(h[0], h[1]); w.y = pkh(h[2], h[3]); *(u32x2*)(orow + 4 * lane + 256 * j) = w; }
}
__device__ __forceinline__ float load_row(const float* xrow, f32x4 (&v)[4], int lane) {
    float s = 0.f;
#pragma unroll
    for (int j = 0; j < 4; ++j) { v[j] = *(const f32x4*)(xrow + 4 * lane + 256 * j); s += (v[j][0] * v[j][0] + v[j][1] * v[j][1]) + (v[j][2] * v[j][2] + v[j][3] * v[j][3]); }
    return __builtin_amdgcn_rsqf(wave_sum(s) * (1.f / DM) + EPS);
}

__device__ __forceinline__ void sb_naive_item(int idx, f16* Q, const f16* __restrict__ K, const f16* __restrict__ V) {
    const int t = idx % SEQ, h = (idx / SEQ) % NH, b = idx / (SEQ * NH);
    f16* qp = Q + (size_t)(b * SEQ + t) * DM + h * HD;
    f16 q[HD]; float o[HD];
#pragma unroll
    for (int d = 0; d < HD; ++d) { q[d] = qp[d]; o[d] = 0.f; }
    float R = 0.f;
    for (int s = t - 1; s >= 0; --s) {
        const f16* kp = K + (size_t)(b * SEQ + s) * DM + h * HD;
        float z = 0.f;
#pragma unroll
        for (int d = 0; d < HD; ++d) z += (float)q[d] * (float)kp[d];
        z = fminf(z, 126.f);
        const float L = log2f(1.f + exp2f(z));
        const float Cc = R + L;
        const float w = exp2f(z - Cc);
        const f16* vp = V + (size_t)(b * SEQ + s) * DM + h * HD;
#pragma unroll
        for (int d = 0; d < HD; ++d) o[d] += w * (float)vp[d];
        R = Cc;
        if (R > 152.f) break;
    }
#pragma unroll
    for (int d = 0; d < HD; ++d) qp[d] = (f16)o[d];
}
__device__ __forceinline__ void moba_naive_item(int idx, f16* Q, const f16* __restrict__ K, const f16* __restrict__ V, const float* __restrict__ kms) {
    const int t = idx % SEQ, h = (idx / SEQ) % NH, b = idx / (SEQ * NH);
    f16* qp = Q + (size_t)(b * SEQ + t) * DM + h * HD;
    f16 q[HD]; float o[HD];
#pragma unroll
    for (int d = 0; d < HD; ++d) { q[d] = qp[d]; o[d] = 0.f; }
    const int own = t / MBLK;
    float v0 = -INFINITY, v1 = -INFINITY, v2 = -INFINITY; int i0 = -1, i1 = -1, i2 = -1;
    for (int j = 0; j < own; ++j) {
        const float* kp = kms + (size_t)(b * NBLK + j) * DM + h * HD;
        float gsc = 0.f;
#pragma unroll
        for (int d = 0; d < HD; ++d) gsc += (float)q[d] * kp[d];
        if (gsc > v0) { v2 = v1; i2 = i1; v1 = v0; i1 = i0; v0 = gsc; i0 = j; }
        else if (gsc > v1) { v2 = v1; i2 = i1; v1 = gsc; i1 = j; }
        else if (gsc > v2) { v2 = gsc; i2 = j; }
    }
    const float slope2 = exp2f(-0.5f * (float)(h + 1)) * LOG2E;
    float m = -INFINITY, l = 0.f;
#pragma unroll
    for (int si = 0; si < 4; ++si) {
        const int j = si == 0 ? i0 : si == 1 ? i1 : si == 2 ? i2 : own;
        if (j < 0) continue;
        const int k_lo = j * MBLK, k_hi = (j == own) ? t : (k_lo + MBLK - 1);
        for (int s = k_lo; s <= k_hi; ++s) {
            const f16* kp = K + (size_t)(b * SEQ + s) * DM + h * HD;
            float z = 0.f;
#pragma unroll
            for (int d = 0; d < HD; ++d) z += (float)q[d] * (float)kp[d];
            z = z - slope2 * (float)(t - s);
            const float mn = fmaxf(m, z);
            const float al = exp2f(m - mn), p = exp2f(z - mn);
            l = l * al + p;
            const f16* vp = V + (size_t)(b * SEQ + s) * DM + h * HD;
#pragma unroll
            for (int d = 0; d < HD; ++d) o[d] = o[d] * al + p * (float)vp[d];
            m = mn;
        }
    }
    const float inv = 1.f / l;
#pragma unroll
    for (int d = 0; d < HD; ++d) qp[d] = (f16)(o[d] * inv);
}


__device__ __forceinline__ int crow16(int i, int h) { return (i & 3) + 8 * (i >> 2) + 4 * h; }
__device__ __forceinline__ f16x8 pack8(const f32x16& v, int s) {
    u32x4 p; p.x = pkh(v[8 * s + 0], v[8 * s + 1]); p.y = pkh(v[8 * s + 2], v[8 * s + 3]); p.z = pkh(v[8 * s + 4], v[8 * s + 5]); p.w = pkh(v[8 * s + 6], v[8 * s + 7]);
    return __builtin_bit_cast(f16x8, p);
}
__device__ __forceinline__ void sb_item(int item, f16* Q, const f16* __restrict__ K, const f16* __restrict__ VT, int lane) {
    const int r = lane & 31, h = lane >> 5;
    const int qg = item & 255, head = (item >> 8) & 15, b = item >> 12;
    const int q0 = qg * 32;
    f16* qrow = Q + (size_t)(b * SEQ + q0 + r) * DM + head * HD;
    f16x8 qf[4];
#pragma unroll
    for (int s = 0; s < 4; ++s) qf[s] = *(const f16x8*)(qrow + 16 * s + 8 * h);
    f16x8 tri[2], ones;
#pragma unroll
    for (int s = 0; s < 2; ++s)
#pragma unroll
        for (int j = 0; j < 8; ++j) { const int k = 16 * s + 8 * (j >> 2) + 4 * h + (j & 3); tri[s][j] = (k >= r) ? (f16)1.0f : (f16)0.0f; }
#pragma unroll
    for (int j = 0; j < 8; ++j) ones[j] = (f16)1.0f;
    f32x16 o0, o1;
#pragma unroll
    for (int i = 0; i < 16; ++i) { o0[i] = 0.f; o1[i] = 0.f; }
    float R = 0.f;
    const f16* kbase = K + (size_t)(b * SEQ + r) * DM + head * HD + 8 * h;
    const f16* vbase = VT + (size_t)(b * DM + head * HD + r) * SEQ + 4 * h;
    for (int key0 = q0; key0 >= 0; key0 -= 32) {
        f16x8 kf[4];
#pragma unroll
        for (int s = 0; s < 4; ++s) kf[s] = *(const f16x8*)(kbase + (size_t)key0 * DM + 16 * s);
        f16x4 va[2][2][2];
#pragma unroll
        for (int d0 = 0; d0 < 2; ++d0)
#pragma unroll
            for (int s = 0; s < 2; ++s) { const f16* vp = vbase + (size_t)(32 * d0) * SEQ + key0 + 16 * s; va[d0][s][0] = *(const f16x4*)vp; va[d0][s][1] = *(const f16x4*)(vp + 8); }
        f32x16 x;
#pragma unroll
        for (int i = 0; i < 16; ++i) x[i] = 0.f;
#pragma unroll
        for (int s = 0; s < 4; ++s) x = __builtin_amdgcn_mfma_f32_32x32x16_f16(kf[s], qf[s], x, 0, 0, 0);
        const bool diag = (key0 == q0);
        f32x16 L;
#pragma unroll
        for (int i = 0; i < 16; ++i) { const float z = __builtin_fminf(x[i], 126.f); x[i] = z; L[i] = __builtin_amdgcn_logf(1.f + __builtin_amdgcn_exp2f(z)); }
        if (diag) {
#pragma unroll
            for (int i = 0; i < 16; ++i) if (crow16(i, h) >= r) L[i] = 0.f;
        }
        const f16x8 lb0 = pack8(L, 0), lb1 = pack8(L, 1);
        f32x16 y, tt;
#pragma unroll
        for (int i = 0; i < 16; ++i) { y[i] = R; tt[i] = 0.f; }
        y = __builtin_amdgcn_mfma_f32_32x32x16_f16(tri[0], lb0, y, 0, 0, 0);
        y = __builtin_amdgcn_mfma_f32_32x32x16_f16(tri[1], lb1, y, 0, 0, 0);
        tt = __builtin_amdgcn_mfma_f32_32x32x16_f16(ones, lb0, tt, 0, 0, 0);
        tt = __builtin_amdgcn_mfma_f32_32x32x16_f16(ones, lb1, tt, 0, 0, 0);
        f32x16 w;
#pragma unroll
        for (int i = 0; i < 16; ++i) w[i] = __builtin_amdgcn_exp2f(x[i] - y[i]);
        if (diag) {
#pragma unroll
            for (int i = 0; i < 16; ++i) if (crow16(i, h) >= r) w[i] = 0.f;
        }
        R += tt[0];
        const f16x8 pb0 = pack8(w, 0), pb1 = pack8(w, 1);
#define VFRAG(d0, s) __builtin_shufflevector(va[d0][s][0], va[d0][s][1], 0, 1, 2, 3, 4, 5, 6, 7)
        o0 = __builtin_amdgcn_mfma_f32_32x32x16_f16(VFRAG(0, 0), pb0, o0, 0, 0, 0);
        o0 = __builtin_amdgcn_mfma_f32_32x32x16_f16(VFRAG(0, 1), pb1, o0, 0, 0, 0);
        o1 = __builtin_amdgcn_mfma_f32_32x32x16_f16(VFRAG(1, 0), pb0, o1, 0, 0, 0);
        o1 = __builtin_amdgcn_mfma_f32_32x32x16_f16(VFRAG(1, 1), pb1, o1, 0, 0, 0);
#undef VFRAG
        if (__all(R >= 152.f)) break;
    }
#pragma unroll
    for (int g = 0; g < 4; ++g) {
        u32x2 w0, w1; w0.x = pkh(o0[4 * g], o0[4 * g + 1]); w0.y = pkh(o0[4 * g + 2], o0[4 * g + 3]); w1.x = pkh(o1[4 * g], o1[4 * g + 1]); w1.y = pkh(o1[4 * g + 2], o1[4 * g + 3]);
        *(u32x2*)(qrow + 8 * g + 4 * h) = w0; *(u32x2*)(qrow + 32 + 8 * g + 4 * h) = w1;
    }
}


typedef __bf16 bf16x2 __attribute__((ext_vector_type(2)));
typedef __bf16 bf16x4 __attribute__((ext_vector_type(4)));
typedef __bf16 bf16x8 __attribute__((ext_vector_type(8)));
__device__ __forceinline__ bf16x8 pack8b(const f32x16& v, int s) {
    u32x4 p; p.x = pkb(v[8 * s + 0], v[8 * s + 1]); p.y = pkb(v[8 * s + 2], v[8 * s + 3]); p.z = pkb(v[8 * s + 4], v[8 * s + 5]); p.w = pkb(v[8 * s + 6], v[8 * s + 7]);
    return __builtin_bit_cast(bf16x8, p);
}
constexpr int MB_OST = 0;
constexpr int MB_L = 256 * 65 * 4;
constexpr int MB_M = MB_L + 1024;
constexpr int MB_CNT = MB_M + 1024;
constexpr int MB_LST = MB_CNT + 128;
constexpr int MB_END = MB_LST + 8192;
#define TOP3_INSERT(v, ix) do { const float v_ = (v); const int i_ = (ix); \
        if (v_ > t0) { t2 = t1; j2 = j1; t1 = t0; j1 = j0; t0 = v_; j0 = i_; } else if (v_ > t1) { t2 = t1; j2 = j1; t1 = v_; j1 = i_; } else if (v_ > t2) { t2 = v_; j2 = i_; } } while (0)
__device__ __forceinline__ void moba_unit(int b, int head, int blk, f16* Q, const f16* __restrict__ K, const __bf16* __restrict__ VT, const float* __restrict__ kms, LAS unsigned char* lds, int tid) {
    const int lane = tid & 63, wave = __builtin_amdgcn_readfirstlane(tid >> 6), r = lane & 31, h = lane >> 5;
    LAS float* ost = (LAS float*)(lds + MB_OST); LAS float* lst_l = (LAS float*)(lds + MB_L); LAS float* mref = (LAS float*)(lds + MB_M);
    LAS int* cnt = (LAS int*)(lds + MB_CNT); LAS unsigned char* qlist = lds + MB_LST;
    const float slope2 = __builtin_amdgcn_exp2f(-0.5f * (float)(head + 1)) * LOG2E;
    const size_t tok0 = (size_t)b * SEQ + (size_t)blk * MBLK;
    const f16* kbase = K + (size_t)b * SEQ * DM + head * HD + 8 * h;
    const __bf16* vbase = VT + (size_t)(b * DM + head * HD + r) * SEQ + 4 * h;
    if (tid < 32) cnt[tid] = 0;
    __syncthreads();
    {
        const int ql = wave * 32 + r;
        const f16* qrow = Q + (tok0 + ql) * DM + head * HD;
        f16x8 qf[4];
#pragma unroll
        for (int s = 0; s < 4; ++s) qf[s] = *(const f16x8*)(qrow + 16 * s + 8 * h);
        f32x16 g;
#pragma unroll
        for (int i = 0; i < 16; ++i) g[i] = 0.f;
#pragma unroll
        for (int s = 0; s < 4; ++s) { const float* kp = kms + (size_t)(b * NBLK + r) * DM + head * HD + 16 * s + 8 * h;
            const f32x4 a0 = *(const f32x4*)kp * (1.f / MBLK), a1 = *(const f32x4*)(kp + 4) * (1.f / MBLK);
            u32x4 p; p.x = pkh(a0[0], a0[1]); p.y = pkh(a0[2], a0[3]); p.z = pkh(a1[0], a1[1]); p.w = pkh(a1[2], a1[3]);
            g = __builtin_amdgcn_mfma_f32_32x32x16_f16(__builtin_bit_cast(f16x8, p), qf[s], g, 0, 0, 0); }
        float t0 = -INFINITY, t1 = -INFINITY, t2 = -INFINITY; int j0 = -1, j1 = -1, j2 = -1;
#pragma unroll
        for (int i = 0; i < 16; ++i) { const int jb = crow16(i, h); if (jb < blk) TOP3_INSERT(g[i], jb); }
        { const float p0 = __shfl_xor(t0, 32), p1 = __shfl_xor(t1, 32), p2 = __shfl_xor(t2, 32); const int q0_ = __shfl_xor(j0, 32), q1_ = __shfl_xor(j1, 32), q2_ = __shfl_xor(j2, 32);
          TOP3_INSERT(p0, q0_); TOP3_INSERT(p1, q1_); TOP3_INSERT(p2, q2_); }
        if (h == 0) {
            if (j0 >= 0) { const int sl = __hip_atomic_fetch_add(cnt + j0, 1, __ATOMIC_RELAXED, __HIP_MEMORY_SCOPE_WORKGROUP); qlist[j0 * 256 + sl] = (unsigned char)ql; }
            if (j1 >= 0) { const int sl = __hip_atomic_fetch_add(cnt + j1, 1, __ATOMIC_RELAXED, __HIP_MEMORY_SCOPE_WORKGROUP); qlist[j1 * 256 + sl] = (unsigned char)ql; }
            if (j2 >= 0) { const int sl = __hip_atomic_fetch_add(cnt + j2, 1, __ATOMIC_RELAXED, __HIP_MEMORY_SCOPE_WORKGROUP); qlist[j2 * 256 + sl] = (unsigned char)ql; }
        }
        f32x16 o0, o1;
#pragma unroll
        for (int i = 0; i < 16; ++i) { o0[i] = 0.f; o1[i] = 0.f; }
        float m = -1e30f, l = 0.f;
#pragma unroll 1
        for (int kt = 0; kt <= wave; ++kt) {
            const size_t key0 = tok0 - (size_t)b * SEQ + 32 * kt;
            f16x8 kf[4];
#pragma unroll
            for (int s = 0; s < 4; ++s) kf[s] = *(const f16x8*)(kbase + (key0 + r) * DM + 16 * s);
            bf16x4 va[2][2][2];
#pragma unroll
            for (int d0 = 0; d0 < 2; ++d0)
#pragma unroll
                for (int s = 0; s < 2; ++s) { const __bf16* vp = vbase + (size_t)(32 * d0) * SEQ + key0 + 16 * s; va[d0][s][0] = *(const bf16x4*)vp; va[d0][s][1] = *(const bf16x4*)(vp + 8); }
            f32x16 x;
#pragma unroll
            for (int i = 0; i < 16; ++i) x[i] = slope2 * (float)(32 * kt + crow16(i, h) - ql);
#pragma unroll
            for (int s = 0; s < 4; ++s) x = __builtin_amdgcn_mfma_f32_32x32x16_f16(kf[s], qf[s], x, 0, 0, 0);
            if (kt == wave) {
#pragma unroll
                for (int i = 0; i < 16; ++i) if (crow16(i, h) > r) x[i] = -INFINITY;
            }
            float tm = x[0];
#pragma unroll
            for (int i = 1; i < 16; ++i) tm = __builtin_fmaxf(tm, x[i]);
            tm = __builtin_fmaxf(tm, __shfl_xor(tm, 32));
            const float mn = __builtin_fmaxf(m, tm);
            const float al = __builtin_amdgcn_exp2f(m - mn);
            m = mn;
            float ps = 0.f;
#pragma unroll
            for (int i = 0; i < 16; ++i) { x[i] = __builtin_amdgcn_exp2f(x[i] - mn); ps += x[i]; }
            l = l * al + ps;
#pragma unroll
            for (int i = 0; i < 16; ++i) { o0[i] *= al; o1[i] *= al; }
            const bf16x8 pb0 = pack8b(x, 0), pb1 = pack8b(x, 1);
#define VFRAGB(d0, s) __builtin_shufflevector(va[d0][s][0], va[d0][s][1], 0, 1, 2, 3, 4, 5, 6, 7)
            o0 = __builtin_amdgcn_mfma_f32_32x32x16_bf16(VFRAGB(0, 0), pb0, o0, 0, 0, 0);
            o0 = __builtin_amdgcn_mfma_f32_32x32x16_bf16(VFRAGB(0, 1), pb1, o0, 0, 0, 0);
            o1 = __builtin_amdgcn_mfma_f32_32x32x16_bf16(VFRAGB(1, 0), pb0, o1, 0, 0, 0);
            o1 = __builtin_amdgcn_mfma_f32_32x32x16_bf16(VFRAGB(1, 1), pb1, o1, 0, 0, 0);
        }
        const float lt = l + __shfl_xor(l, 32);
        if (h == 0) { lst_l[ql] = lt; mref[ql] = m; }
#pragma unroll
        for (int i = 0; i < 16; ++i) { ost[ql * 65 + crow16(i, h)] = o0[i]; ost[ql * 65 + 32 + crow16(i, h)] = o1[i]; }
    }
    __syncthreads();
    {
        int total = 0;
        for (int j = 0; j < blk; ++j) total += (cnt[j] + 31) >> 5;
        total = __builtin_amdgcn_readfirstlane(total);
#pragma unroll 1
        for (int n = wave; n < total; n += NWAVES) {
            int j = 0, accg = 0;
            for (;; ++j) { const int ng = (cnt[j] + 31) >> 5; if (n < accg + ng) break; accg += ng; }
            j = __builtin_amdgcn_readfirstlane(j); const int grp = n - __builtin_amdgcn_readfirstlane(accg);
            const int cj = __builtin_amdgcn_readfirstlane(cnt[j]);
            const int li = grp * 32 + r; const bool valid = li < cj;
            const int ql = qlist[j * 256 + (valid ? li : 0)];
            const f16* qrow = Q + (tok0 + ql) * DM + head * HD;
            f16x8 qf[4];
#pragma unroll
            for (int s = 0; s < 4; ++s) qf[s] = *(const f16x8*)(qrow + 16 * s + 8 * h);
            const float mr = mref[ql];
            const float cb = slope2 * (float)(256 * (j - blk) - ql) - mr;
            f32x16 o0, o1;
#pragma unroll
            for (int i = 0; i < 16; ++i) { o0[i] = 0.f; o1[i] = 0.f; }
            float ps = 0.f;
            const size_t keyb = (size_t)j * MBLK;
#pragma unroll 1
            for (int kt = 0; kt < 8; ++kt) {
                const size_t key0 = keyb + 32 * kt;
                f16x8 kf[4];
#pragma unroll
                for (int s = 0; s < 4; ++s) kf[s] = *(const f16x8*)(kbase + (key0 + r) * DM + 16 * s);
                bf16x4 va[2][2][2];
#pragma unroll
                for (int d0 = 0; d0 < 2; ++d0)
#pragma unroll
                    for (int s = 0; s < 2; ++s) { const __bf16* vp = vbase + (size_t)(32 * d0) * SEQ + key0 + 16 * s; va[d0][s][0] = *(const bf16x4*)vp; va[d0][s][1] = *(const bf16x4*)(vp + 8); }
                f32x16 x;
#pragma unroll
                for (int i = 0; i < 16; ++i) x[i] = slope2 * (float)(32 * kt + crow16(i, h)) + cb;
#pragma unroll
                for (int s = 0; s < 4; ++s) x = __builtin_amdgcn_mfma_f32_32x32x16_f16(kf[s], qf[s], x, 0, 0, 0);
#pragma unroll
                for (int i = 0; i < 16; ++i) { x[i] = valid ? __builtin_amdgcn_exp2f(x[i]) : 0.f; ps += x[i]; }
                const bf16x8 pb0 = pack8b(x, 0), pb1 = pack8b(x, 1);
                o0 = __builtin_amdgcn_mfma_f32_32x32x16_bf16(VFRAGB(0, 0), pb0, o0, 0, 0, 0);
                o0 = __builtin_amdgcn_mfma_f32_32x32x16_bf16(VFRAGB(0, 1), pb1, o0, 0, 0, 0);
                o1 = __builtin_amdgcn_mfma_f32_32x32x16_bf16(VFRAGB(1, 0), pb0, o1, 0, 0, 0);
                o1 = __builtin_amdgcn_mfma_f32_32x32x16_bf16(VFRAGB(1, 1), pb1, o1, 0, 0, 0);
            }
#undef VFRAGB
            if (valid) {
                __hip_atomic_fetch_add(lst_l + ql, ps, __ATOMIC_RELAXED, __HIP_MEMORY_SCOPE_WORKGROUP);
#pragma unroll
                for (int i = 0; i < 16; ++i) { __hip_atomic_fetch_add(ost + ql * 65 + crow16(i, h), o0[i], __ATOMIC_RELAXED, __HIP_MEMORY_SCOPE_WORKGROUP);
                                               __hip_atomic_fetch_add(ost + ql * 65 + 32 + crow16(i, h), o1[i], __ATOMIC_RELAXED, __HIP_MEMORY_SCOPE_WORKGROUP); }
            }
        }
    }
    __syncthreads();
    {
        const int ql = tid >> 1, dh = (tid & 1) * 32; const float inv = 1.f / lst_l[ql];
        f16* orow = Q + (tok0 + ql) * DM + head * HD + dh;
#pragma unroll
        for (int c8 = 0; c8 < 4; ++c8) { float v[8];
#pragma unroll
            for (int e = 0; e < 8; ++e) v[e] = ost[ql * 65 + dh + c8 * 8 + e] * inv;
            u32x4 w; w.x = pkh(v[0], v[1]); w.y = pkh(v[2], v[3]); w.z = pkh(v[4], v[5]); w.w = pkh(v[6], v[7]);
            *(u32x4*)(orow + c8 * 8) = w; }
    }
    __syncthreads();
}

constexpr int N_PHASES = 16;
struct Args { const float* in[22]; float* out; unsigned char* ws; int ph_lo, ph_hi, bar_region, pad; };
__global__ void __launch_bounds__(NTHREADS, 2) mk_fwd(Args args) {
    extern __shared__ __attribute__((aligned(16))) unsigned char lds_raw[];
    LAS unsigned char* lds = (LAS unsigned char*)lds_raw;
    volatile LAS unsigned* MISC = (volatile LAS unsigned*)(lds + MISC_OFF);
    const int tid = threadIdx.x, lane = tid & 63, wave = __builtin_amdgcn_readfirstlane(tid >> 6);
    const int G = gridDim.x; const int bx = blockIdx.x; const int vcu = (G % 8 == 0) ? (bx % 8) * (G / 8) + bx / 8 : bx;
    const int gw = vcu * NWAVES + wave, NGW = G * NWAVES;
    unsigned char* ws = args.ws;
    unsigned* ctl = (unsigned*)(ws + WS_CTL);
    const float* x = args.in[0];      const float* c = args.in[1];
    const float* w_ada = args.in[2];  const float* b_ada = args.in[3];
    const float* g_attn = args.in[4]; const float* g_ffn = args.in[5];
    const float* w_qkv_a = args.in[6]; const float* w_o_a = args.in[7];
    const float* w_ada_kv = args.in[8]; const float* b_ada_kv = args.in[9];
    const float* g_kv = args.in[10];  const float* w_kv = args.in[11];
    const float* w_q_b = args.in[12]; const float* w_o_b = args.in[13];
    const float* w_rg = args.in[14];  const float* b_rg = args.in[15];
    const float* w_re = args.in[16];  const float* b_re = args.in[17];
    const float* w_gate = args.in[18]; const float* w_up = args.in[19];
    const float* w_down = args.in[20]; const float* g_final = args.in[21];
    float* out = args.out;
    float* mod = (float*)(ws + WS_MOD); float* modkv = mod + 2 * 4 * 6144;
    int* list = (int*)(ws + WS_LIST); float* cw = (float*)(ws + WS_CW); float* kms = (float*)(ws + WS_KMS);
    f16* Wqkv0 = (f16*)(ws + WS_WQKV0); f16* Wo0 = (f16*)(ws + WS_WO0); f16* Wkv1 = (f16*)(ws + WS_WKV1); f16* Wq1 = (f16*)(ws + WS_WQ1); f16* Wo1 = (f16*)(ws + WS_WO1);
    f16* Wgu = (f16*)(ws + WS_WGU); f16* Wd2 = (f16*)(ws + WS_WD2);
    f16* A1 = (f16*)(ws + WS_A1); f16* A2 = (f16*)(ws + WS_A2); f16* A3 = (f16*)(ws + WS_A3); f16* A4 = (f16*)(ws + WS_A4); f16* A5 = (f16*)(ws + WS_A5); f16* HID = (f16*)(ws + WS_HID);
    int* ccnt = (int*)(ctl + CW_CNT);

    for (int u = tid; u < (LDS_BYTES - LDSCTL_OFF) / 4; u += NTHREADS) ((LAS unsigned*)(lds + LDSCTL_OFF))[u] = 0u;
    __syncthreads();
    const bool use_bar = (args.ph_hi - args.ph_lo) > 1;
    XcdBarrier bar; bar.bar = ctl + CW_BAR + args.bar_region * XCD_BAR_WORDS; bar.x = 0; bar.st = nullptr;
    if (use_bar) bar = xcd_barrier_post(ctl + CW_BAR + args.bar_region * XCD_BAR_WORDS, MISC + 8);
    const int lo = args.ph_lo, hi = args.ph_hi;
#define IN(k) (lo <= (k) && (k) < hi)
#define SEAM(k) do { if (IN(k) && IN((k) + 1)) xcd_barrier(bar); } while (0)

    if (IN(0)) {
        for (int i = gw * 64 + lane; i < NB * NBLK * DM; i += NGW * 64) kms[i] = 0.f;
        {
            LAS float* red = (LAS float*)lds;
            for (int it = vcu; it < 224; it += G) {
                if (it < 96) mod_item(c, w_ada, b_ada, mod, 6144, it * 64, red, tid);
                else if (it < 192) mod_item(c, w_ada + (size_t)DM * 6144, b_ada + 6144, mod + 4 * 6144, 6144, (it - 96) * 64, red, tid);
                else mod_item(c, w_ada_kv, b_ada_kv, modkv, 2048, (it - 192) * 64, red, tid);
            }
        }
        LAS float* scr = (LAS float*)(lds + 16384 + wave * 12288);
        for (int it = gw; it < 24576; it += NGW) {
            if (it < 1536) { tr_item(w_qkv_a, 3072, 64 * (it / 96), 32 * (it % 96), Wqkv0, DM, 32 * (it % 96), 0, scr, lane); continue; }
            if (it < 2048) { const int r = it - 1536; tr_item(w_o_a, DM, 64 * (r / 32), 32 * (r % 32), Wo0, DM, 32 * (r % 32), 0, scr, lane); continue; }
            if (it < 3072) { const int r = it - 2048; tr_item(w_kv, 2048, 64 * (r / 64), 32 * (r % 64), Wkv1, DM, 32 * (r % 64), 0, scr, lane); continue; }
            if (it < 3584) { const int r = it - 3072; tr_item(w_q_b, DM, 64 * (r / 32), 32 * (r % 32), Wq1, DM, 32 * (r % 32), 0, scr, lane); continue; }
            if (it < 4096) { const int r = it - 3584; tr_item(w_o_b, DM, 64 * (r / 32), 32 * (r % 32), Wo1, DM, 32 * (r % 32), 0, scr, lane); continue; }
            if (it < 12288) { const int r = it - 4096, mat = r >> 7, sub = r & 127; const int le = mat >> 1, which = mat & 1, kb = sub >> 3, nb = sub & 7;
                const float* src = (which ? w_up : w_gate) + (size_t)le * DM * EFF; const int n0 = 32 * nb;
                tr_item(src, EFF, 64 * kb, n0, Wgu + (size_t)le * 512 * DM, DM, 256 * (n0 >> 7) + 128 * which + (n0 & 127), 0, scr, lane); continue; }
            { const int r = it - 12288, mat = r >> 7, sub = r & 127; const int lc = mat >> 1, side = mat & 1, kb = sub >> 5, nb = sub & 31;
                const int layer = lc / NCLS, cls = lc % NCLS, gq = cls / 6, p = cls % 6; const int a = p < 3 ? 0 : (p < 5 ? 1 : 2), bb = p < 3 ? p + 1 : (p < 5 ? p - 1 : 3);
                const int e = gq * 4 + (side ? bb : a);
                tr_item(w_down + (size_t)(layer * NE + e) * EFF * DM, DM, 64 * kb, 32 * nb, Wd2 + (size_t)lc * DM * 512, 512, 32 * nb, 256 * side, scr, lane); }
        }
    }
    SEAM(0);
    if (IN(1)) {
        for (int ch = gw; ch < MT / 16; ch += NGW) {
        const int row0 = ch * 16, b = row0 / SEQ; Affine A; load_affine(A, g_attn, mod + (size_t)b * 6144 + 1024, mod + (size_t)b * 6144, lane);
        for (int r = row0; r < row0 + 16; ++r) { f32x4 v[4]; const float rs = load_row(x + (size_t)r * DM, v, lane); store_h(A1 + (size_t)r * DM, v, rs, A, lane); } }
    }
    SEAM(1);
    if (IN(2)) {
        { pg8::Gemm g{(const char*)A1, (const char*)Wqkv0, DM, DM, DM}; pg8::StaticOrder S; S.init(MT, 2048, G, bx, DM, DM);
          EpiF16 E{A3, DM, DM, (size_t)(WS_A4 - WS_A3) / 2, DM, QSCALE, 0};
          pg8::gemm_phase<EpiF16, pg8::StaticOrder, true, false>(lds + RING_OFF, g, S, E); }
        { pg8::Gemm g{(const char*)(Wqkv0 + (size_t)2048 * DM), (const char*)A1, DM, DM, DM}; pg8::StaticOrder S; S.init(DM, MT, G, bx, DM, DM);
          EpiF16 E{A5, SEQ, SEQ, (size_t)DM * SEQ, 0, 1.f, 0};
          pg8::gemm_phase<EpiF16, pg8::StaticOrder, true, false>(lds + RING_OFF, g, S, E); }
    }
    SEAM(2);
    if (IN(3)) { for (int item = gw; item < NB * NH * (SEQ / 32); item += NGW) sb_item(item, A3, A4, A5, lane); }
    SEAM(3);
    if (IN(4)) {
        pg8::Gemm g{(const char*)A3, (const char*)Wo0, DM, DM, DM}; pg8::StaticOrder S; S.init(MT, DM, G, bx, DM, DM);
        EpiResid E{x, out, mod + 2048, 6144};
        pg8::gemm_phase<EpiResid, pg8::StaticOrder, true, false>(lds + RING_OFF, g, S, E);
    }
    SEAM(4);
#define ROUTER_PHASE(LAYER) do { \
        LAS float* wl = (LAS float*)lds; \
        const float* wrg = w_rg + (LAYER) * DM * 4; const float* wre = w_re + (LAYER) * DM * 16; \
        for (int idx = tid; idx < DM * 20; idx += NTHREADS) { const int k = idx / 20, o = idx % 20; const int j = k >> 8, rem = k & 255, l = rem >> 2, e = rem & 3; \
            wl[(j * 64 + l) * 84 + e * 20 + o] = o < 4 ? wrg[k * 4 + o] : wre[k * 16 + o - 4]; } \
        __syncthreads(); \
        const float* md = mod + (size_t)(LAYER) * 4 * 6144; \
        for (int ch = gw; ch < MT / 16; ch += NGW) { \
        const int row0 = ch * 16, b = row0 / SEQ; Affine A; load_affine(A, g_ffn + (LAYER) * DM, md + (size_t)b * 6144 + 4096, md + (size_t)b * 6144 + 3072, lane); \
        float brg[4], bre[16]; \
        _Pragma("unroll") for (int i = 0; i < 4; ++i) brg[i] = b_rg[(LAYER) * 4 + i]; \
        _Pragma("unroll") for (int i = 0; i < 16; ++i) bre[i] = b_re[(LAYER) * 16 + i]; \
        int mycls = 0; float mylo = 0.f, myhi = 0.f; \
        for (int rr = 0; rr < 16; ++rr) { const int r = row0 + rr; f32x4 v[4]; const float rs = load_row(out + (size_t)r * DM, v, lane); store_h(A1 + (size_t)r * DM, v, rs, A, lane); \
            float p[20]; _Pragma("unroll") for (int o = 0; o < 20; ++o) p[o] = 0.f; \
            _Pragma("unroll") for (int j = 0; j < 4; ++j) { const f32x4 h = v[j] * rs * A.a[j] + A.s[j]; \
                _Pragma("unroll") for (int e = 0; e < 4; ++e) { const LAS f32x4* wp = (const LAS f32x4*)(wl + (j * 64 + lane) * 84 + e * 20); \
                    _Pragma("unroll") for (int q4 = 0; q4 < 5; ++q4) { const f32x4 wv = wp[q4]; \
                        p[q4 * 4 + 0] += h[e] * wv[0]; p[q4 * 4 + 1] += h[e] * wv[1]; p[q4 * 4 + 2] += h[e] * wv[2]; p[q4 * 4 + 3] += h[e] * wv[3]; } } \
                asm volatile("" ::: "memory"); } \
            _Pragma("unroll") for (int o = 0; o < 20; ++o) p[o] = wave_sum(p[o]); \
            float lg[4]; _Pragma("unroll") for (int i = 0; i < 4; ++i) lg[i] = p[i] + brg[i]; \
            int gs = 0; float mx = lg[0]; \
            _Pragma("unroll") for (int i = 1; i < 4; ++i) if (lg[i] > mx) { mx = lg[i]; gs = i; } \
            float den = 0.f; _Pragma("unroll") for (int i = 0; i < 4; ++i) den += __expf(lg[i] - mx); \
            const float pg = 1.f / den; \
            float le[4]; _Pragma("unroll") for (int i = 0; i < 4; ++i) { le[i] = gs == 0 ? p[4 + i] + bre[i] : gs == 1 ? p[8 + i] + bre[4 + i] : gs == 2 ? p[12 + i] + bre[8 + i] : p[16 + i] + bre[12 + i]; } \
            int a0 = 0; float va = le[0]; \
            _Pragma("unroll") for (int i = 1; i < 4; ++i) if (le[i] > va) { va = le[i]; a0 = i; } \
            int a1 = -1; float vb = -INFINITY; \
            _Pragma("unroll") for (int i = 0; i < 4; ++i) if (i != a0 && le[i] > vb) { vb = le[i]; a1 = i; } \
            const float e1 = __expf(vb - va), dn = 1.f / (1.f + e1); const float c0 = pg * dn, c1 = pg * e1 * dn;     \
            const int ea = a0 < a1 ? a0 : a1, eb = a0 < a1 ? a1 : a0; const float wlo = a0 < a1 ? c0 : c1, whi = a0 < a1 ? c1 : c0; \
            const int cls = gs * 6 + (ea * (7 - ea)) / 2 + (eb - ea - 1); \
            if (lane == rr) { mycls = cls; mylo = wlo; myhi = whi; } } \
        if (lane < 16) { const int tok = row0 + lane; const int slot = atomicAdd(ccnt + (LAYER) * NCLS + mycls, 1); list[mycls * MT + slot] = tok; cw[tok * 2] = mylo; cw[tok * 2 + 1] = myhi; } } \
    } while (0)
#define MOE_TABLE(LAYER) do { \
        LAS int* tab = (LAS int*)(lds + LDSCTL_OFF); \
        if (tid == 0) { int acc_ = 0; for (int j = 0; j < NCLS; ++j) { const int cn = ccnt[(LAYER) * NCLS + j]; tab[j] = acc_; tab[32 + j] = cn; acc_ += (cn + 255) >> 8; } tab[24] = acc_; } \
        __syncthreads(); } while (0)
#define MOE1_PHASE(LAYER) do { MOE_TABLE(LAYER); \
        MoeSched S{(const LAS int*)(lds + LDSCTL_OFF), list, G, bx, (LAYER), 1}; \
        pg8::Gemm g{(const char*)A1, (const char*)Wgu, DM, DM, DM}; EpiMoe1 E{HID, cw, S}; \
        pg8::gemm_phase<EpiMoe1, MoeSched, true, true>(lds + RING_OFF, g, S, E); } while (0)
#define MOE2_PHASE(LAYER) do { MOE_TABLE(LAYER); \
        MoeSched S{(const LAS int*)(lds + LDSCTL_OFF), list, G, bx, (LAYER), 2}; \
        pg8::Gemm g{(const char*)HID, (const char*)Wd2, 512, 512, 512}; EpiMoe2 E{out, mod + (size_t)(LAYER) * 4 * 6144 + 5120, 6144, S}; \
        pg8::gemm_phase<EpiMoe2, MoeSched, true, false>(lds + RING_OFF, g, S, E); } while (0)
    if (IN(5)) { ROUTER_PHASE(0); }
    SEAM(5);
    if (IN(6)) { MOE1_PHASE(0); }
    SEAM(6);
    if (IN(7)) { MOE2_PHASE(0); }
    SEAM(7);
    if (IN(8)) {
        for (int ch = gw; ch < MT / 16; ch += NGW) {
        const int row0 = ch * 16, b = row0 / SEQ; Affine Akv, Aq;
        load_affine(Akv, g_kv, modkv + (size_t)b * 2048 + 1024, modkv + (size_t)b * 2048, lane);
        load_affine(Aq, g_attn + DM, mod + 4 * 6144 + (size_t)b * 6144 + 1024, mod + 4 * 6144 + (size_t)b * 6144, lane);
        for (int r = row0; r < row0 + 16; ++r) { f32x4 v[4]; const float rs = load_row(out + (size_t)r * DM, v, lane);
            store_h(A1 + (size_t)r * DM, v, rs, Akv, lane); store_h(A2 + (size_t)r * DM, v, rs, Aq, lane); } }
    }
    SEAM(8);
    if (IN(9)) {
        { pg8::Gemm g{(const char*)A1, (const char*)Wkv1, DM, DM, DM}; pg8::StaticOrder S; S.init(MT, DM, G, bx, DM, DM);
          EpiKV1 E{A4, DM, 0, 0, kms};
          pg8::gemm_phase<EpiKV1, pg8::StaticOrder, true, false>(lds + RING_OFF, g, S, E); }
        { pg8::Gemm g{(const char*)(Wkv1 + (size_t)DM * DM), (const char*)A1, DM, DM, DM}; pg8::StaticOrder S; S.init(DM, MT, G, bx, DM, DM);
          EpiF16 E{A5, SEQ, SEQ, (size_t)DM * SEQ, 0, 1.f, 1};
          pg8::gemm_phase<EpiF16, pg8::StaticOrder, true, false>(lds + RING_OFF, g, S, E); }
        { pg8::Gemm g{(const char*)A2, (const char*)Wq1, DM, DM, DM}; pg8::StaticOrder S; S.init(MT, DM, G, bx, DM, DM);
          EpiF16 E{A3, DM, 0, 0, DM, QSCALE, 0};
          pg8::gemm_phase<EpiF16, pg8::StaticOrder, true, false>(lds + RING_OFF, g, S, E); }
    }
    SEAM(9);
    if (IN(10)) {
        for (int uu = vcu; uu < NB * NH * 4; uu += G) { const int bh = uu >> 2, sq = uu & 3;
#pragma unroll 1
            for (int ii = 0; ii < 8; ++ii) { const int blk = (ii >> 1) * 8 + ((ii & 1) ? 7 - sq : sq);
                moba_unit(bh / NH, bh % NH, blk, A3, A4, (const __bf16*)A5, kms, lds, tid); } }
    }
    SEAM(10);
    if (IN(11)) {
        pg8::Gemm g{(const char*)A3, (const char*)Wo1, DM, DM, DM}; pg8::StaticOrder S; S.init(MT, DM, G, bx, DM, DM);
        EpiResid E{out, out, mod + 4 * 6144 + 2048, 6144};
        pg8::gemm_phase<EpiResid, pg8::StaticOrder, true, false>(lds + RING_OFF, g, S, E);
    }
    SEAM(11);
    if (IN(12)) { ROUTER_PHASE(1); }
    SEAM(12);
    if (IN(13)) { MOE1_PHASE(1); }
    SEAM(13);
    if (IN(14)) { MOE2_PHASE(1); }
    SEAM(14);
    if (IN(15)) {
        f32x4 gf[4];
#pragma unroll
        for (int j = 0; j < 4; ++j) gf[j] = *(const f32x4*)(g_final + 4 * lane + 256 * j);
        for (int ch = gw; ch < MT / 16; ch += NGW) { const int row0 = ch * 16;
        for (int r = row0; r < row0 + 16; ++r) { f32x4 v[4]; const float rs = load_row(out + (size_t)r * DM, v, lane);
#pragma unroll
            for (int j = 0; j < 4; ++j) *(f32x4*)(out + (size_t)r * DM + 4 * lane + 256 * j) = v[j] * rs * gf[j]; } }
    }
#undef IN
#undef SEAM
}

extern "C" void kernel_launch(void* const* d_in, const int* in_sizes, int n_in, void* d_out, int out_size, void* d_ws, size_t ws_size, hipStream_t stream) {
    static int grid = 0;
    if (grid == 0) {
        if (n_in != 22 || out_size != MT * DM || ws_size < WS_END) { fprintf(stderr, "kernel_launch: unexpected shapes (n_in %d out %d ws %zu)\n", n_in, out_size, ws_size); grid = -1; return; }
        int dev = 0, cus = 0, per_cu = 0;
        if (hipGetDevice(&dev) != hipSuccess || hipDeviceGetAttribute(&cus, hipDeviceAttributeMultiprocessorCount, dev) != hipSuccess) { grid = -1; return; }
        if (hipFuncSetAttribute((const void*)mk_fwd, hipFuncAttributeMaxDynamicSharedMemorySize, LDS_BYTES) != hipSuccess) { fprintf(stderr, "kernel_launch: hipFuncSetAttribute failed\n"); grid = -1; return; }
        if (hipOccupancyMaxActiveBlocksPerMultiprocessor(&per_cu, (const void*)mk_fwd, NTHREADS, LDS_BYTES) != hipSuccess || per_cu < 1) { fprintf(stderr, "kernel_launch: occupancy query says %d\n", per_cu); }
        (void)hipGetLastError();
        grid = cus;
    }
    if (grid < 0) return;
    (void)hipMemsetAsync((char*)d_ws + WS_CTL, 0, CTL_ZERO_BYTES, stream);
    Args a{};
    for (int i = 0; i < 22; ++i) a.in[i] = (const float*)d_in[i];
    a.out = (float*)d_out; a.ws = (unsigned char*)d_ws;
    f16* A3 = (f16*)((char*)d_ws + WS_A3); f16* A4 = (f16*)((char*)d_ws + WS_A4); f16* A5 = (f16*)((char*)d_ws + WS_A5); float* kms = (float*)((char*)d_ws + WS_KMS);
#ifndef MK_FUSE
#define MK_FUSE 1
#endif
    int region = 0;
    auto run = [&](int lo, int hi) {
        if (MK_FUSE) { a.ph_lo = lo; a.ph_hi = hi; a.bar_region = region++; hipLaunchKernelGGL(mk_fwd, dim3(grid), dim3(NTHREADS), LDS_BYTES, stream, a); }
        else for (int p = lo; p < hi; ++p) { a.ph_lo = p; a.ph_hi = p + 1; a.bar_region = 0; hipLaunchKernelGGL(mk_fwd, dim3(grid), dim3(NTHREADS), LDS_BYTES, stream, a); }
    };
    run(0, N_PHASES);
}
```

```cpp
#include <hip/hip_runtime.h>
#include <cstdio>
#include <cstdint>

#define GAS __attribute__((address_space(1)))
#define LAS __attribute__((address_space(3)))
typedef _Float16 f16;
typedef _Float16 f16x2 __attribute__((ext_vector_type(2)));
typedef _Float16 f16x4 __attribute__((ext_vector_type(4)));
typedef _Float16 f16x8 __attribute__((ext_vector_type(8)));
typedef float f32x2 __attribute__((ext_vector_type(2)));
typedef float f32x4 __attribute__((ext_vector_type(4)));
typedef float f32x16 __attribute__((ext_vector_type(16)));
typedef unsigned u32x2 __attribute__((ext_vector_type(2)));
typedef unsigned u32x4 __attribute__((ext_vector_type(4)));

constexpr int NB = 4, SEQ = 8192, DM = 1024, MT = NB * SEQ, NH = 16, HD = 64;
constexpr int NBLK = 32, MBLK = 256, NE = 16, EFF = 256, NCLS = 24;
constexpr float EPS = 1e-6f;
constexpr float LOG2E = 1.4426950408889634f;
constexpr float QSCALE = 0.125f * LOG2E;
constexpr int NWAVES = 8, NTHREADS = 512;

__device__ __forceinline__ unsigned pkh(float lo, float hi) { f32x2 v = {lo, hi}; f16x2 h = __builtin_convertvector(v, f16x2); return __builtin_bit_cast(unsigned, h); }
typedef __bf16 bf16x2_t __attribute__((ext_vector_type(2)));
__device__ __forceinline__ unsigned pkb(float lo, float hi) { f32x2 v = {lo, hi}; bf16x2_t h = __builtin_convertvector(v, bf16x2_t); return __builtin_bit_cast(unsigned, h); }
__device__ __forceinline__ float wave_sum(float v) {
#pragma unroll
    for (int o = 1; o < 64; o <<= 1) v += __shfl_xor(v, o);
    return v;
}

namespace pg8 {
constexpr int BM = 256, BK = 64, HALF = 128, HTB = HALF * BK * 2, STAGE_BYTES = 8 * HTB, NXCD = 8, WGM = 8;
__host__ __device__ __forceinline__ int lds_byte(int r, int c) { const int st = (r >> 4) * 2 + (c >> 5), rr = r & 15, cc = c & 31, ob = rr * 64 + cc * 2; return st * 1024 + (ob ^ (((ob >> 9) & 1) << 5)); }
__host__ __device__ __forceinline__ void stage_rc(int b, int& R, int& C) { const int st = b / 1024, sb = b % 1024, swz = sb ^ (((sb >> 9) & 1) << 5); R = (st >> 1) * 16 + swz / 64; C = (st & 1) * 32 + (swz % 64) / 2; }
__host__ __device__ __forceinline__ int perm32(int rho) { const int n = rho >> 4, i = rho & 15; return 8 * (i >> 2) + 4 * n + (i & 3); }

struct Unit { int pm, pn, cls, tin; };
struct Gemm { const char* A; const char* Bt; int K, lda, ldb; };

struct StaticOrder {
    int nM, nN, nwg, G, c, lda2, ldb2;
    __device__ __forceinline__ void init(int M, int N, int G_, int c_, int lda, int ldb) { nM = M / BM; nN = N / BM; nwg = nM * nN; G = G_; c = c_; lda2 = lda * 2; ldb2 = ldb * 2; }
    __device__ __forceinline__ bool next(int i, Unit& u) const {
        const long L = (long)i * G + c; if (L >= nwg) return false;
        int wgid = (int)L; { const int q = nwg / NXCD, r = nwg % NXCD, xcd = wgid % NXCD, off = wgid / NXCD; wgid = (xcd < r ? xcd * (q + 1) : r * (q + 1) + (xcd - r) * q) + off; }
        const int nig = WGM * nN, gid = wgid / nig, fm = gid * WGM, gsz = (nM - fm) < WGM ? (nM - fm) : WGM;
        u.pm = fm + ((wgid % nig) % gsz); u.pn = (wgid % nig) / gsz; u.cls = 0; u.tin = 0; return true;
    }
    __device__ __forceinline__ size_t a_off(const Unit& u) const { return (size_t)u.pm * BM * lda2; }
    __device__ __forceinline__ size_t b_off(const Unit& u) const { return (size_t)u.pn * BM * ldb2; }
    __device__ __forceinline__ int row_tok(const Unit&, int) const { return 0; }
};

template <class Epi, class Sched, bool ALIGN_EPI, bool GATHER>
__device__ __forceinline__ void gemm_phase(LAS unsigned char* lds, const Gemm g, const Sched& S, const Epi& E) {
    const int tid = threadIdx.x, wid = __builtin_amdgcn_readfirstlane(tid >> 6), lane = tid & 63, wr = wid >> 2, wc = wid & 3, fr = lane & 15, fq = lane >> 4;
    const int K = g.K, nt = K / BK;
    int Rr[2], Cc[2];
    unsigned cva0[2], cva1[2], nva0[2], nva1[2], voffB[2];
#pragma unroll
    for (int i = 0; i < 2; ++i) { int R, C; stage_rc(tid * 16 + i * 8192, R, C); Rr[i] = R; Cc[i] = C; const int Rb = Epi::PERM ? ((R & ~31) + perm32(R & 31)) : R;
        cva0[i] = (unsigned)(R * g.lda + C) * 2u; cva1[i] = (unsigned)((R + HALF) * g.lda + C) * 2u; nva0[i] = cva0[i]; nva1[i] = cva1[i];
        voffB[i] = (unsigned)(Rb * g.ldb + C) * 2u; }
    const size_t kstep = (size_t)(BK * 2);
    const size_t hstepB = (size_t)HALF * g.ldb * 2;
    const unsigned ldsw = (unsigned)wid * 1024u;
    const int aoff = lds_byte(wr * 64 + fr, fq * 8), boff = lds_byte(wc * 32 + fr, fq * 8);
#define PG8_SA(b, h) (((b) * 2 + (h)) * HTB)
#define PG8_SB(b, h) ((4 + (b) * 2 + (h)) * HTB)
#define PG8_STAGE(bufoff, gbase, voff) do { _Pragma("unroll") for (int _i = 0; _i < 2; ++_i) \
        __builtin_amdgcn_global_load_lds((const unsigned*)((const char*)(gbase) + (voff)[_i]), (LAS unsigned*)(lds + (bufoff) + ldsw + _i * 8192), 16, 0, 0); } while (0)
#define PG8_LDA(dst, b, h) do { _Pragma("unroll") for (int m = 0; m < 4; ++m) _Pragma("unroll") for (int k = 0; k < 2; ++k) dst[m][k] = *(const LAS f16x8*)(lds + PG8_SA(b, h) + aoff + m * 2048 + k * 1024); } while (0)
#define PG8_LDB(dst, b, h) do { _Pragma("unroll") for (int n = 0; n < 2; ++n) _Pragma("unroll") for (int k = 0; k < 2; ++k) dst[n][k] = *(const LAS f16x8*)(lds + PG8_SB(b, h) + boff + n * 2048 + k * 1024); } while (0)
#define PG8_MMA(ai, bj, At, Bt) do { __builtin_amdgcn_s_setprio(1); _Pragma("unroll") for (int m = 0; m < 4; ++m) _Pragma("unroll") for (int n = 0; n < 2; ++n) _Pragma("unroll") for (int k = 0; k < 2; ++k) \
        acc[ai][bj][m][n] = __builtin_amdgcn_mfma_f32_16x16x32_f16(Bt[n][k], At[m][k], acc[ai][bj][m][n], 0, 0, 0); __builtin_amdgcn_s_setprio(0); } while (0)
#define PG8_WAIT_V(n) asm volatile("s_waitcnt vmcnt(" #n ")" ::: "memory")
#define PG8_WAIT_L(n) asm volatile("s_waitcnt lgkmcnt(" #n ")" ::: "memory")
#define PG8_BAR __builtin_amdgcn_s_barrier()
#define PG8_SCHED __builtin_amdgcn_sched_barrier(0)
#define PG8_GATHER_V(dst0, dst1, U) do { _Pragma("unroll") for (int _i = 0; _i < 2; ++_i) { \
        dst0[_i] = (unsigned)(S.row_tok(U, Rr[_i]) * g.lda + Cc[_i]) * 2u; dst1[_i] = (unsigned)(S.row_tok(U, Rr[_i] + HALF) * g.lda + Cc[_i]) * 2u; } } while (0)
    Unit cur, nxt; int ui = 0;
    if (!S.next(0, cur)) return;
    f32x4 acc[2][2][4][2];
#pragma unroll
    for (int a = 0; a < 2; ++a)
#pragma unroll
        for (int b = 0; b < 2; ++b)
#pragma unroll
            for (int m = 0; m < 4; ++m)
#pragma unroll
                for (int n = 0; n < 2; ++n) acc[a][b][m][n] = (f32x4){0.f, 0.f, 0.f, 0.f};
    f16x8 At[4][2], B0[2][2], B1[2][2];
    if constexpr (GATHER) { PG8_GATHER_V(cva0, cva1, cur); }
    const char* cA = g.A + (GATHER ? (size_t)0 : S.a_off(cur)); const char* cB = g.Bt + S.b_off(cur);
    PG8_STAGE(PG8_SB(0, 0), cB, voffB); PG8_STAGE(PG8_SB(0, 1), cB + hstepB, voffB); PG8_STAGE(PG8_SA(0, 0), cA, cva0); PG8_STAGE(PG8_SA(0, 1), cA, cva1);
    if (wr == 1) PG8_BAR;
    PG8_WAIT_V(2); PG8_BAR;
    PG8_STAGE(PG8_SB(1, 0), cB + kstep, voffB); PG8_STAGE(PG8_SA(1, 0), cA + kstep, cva0); PG8_STAGE(PG8_SB(1, 1), cB + hstepB + kstep, voffB);
    PG8_WAIT_V(6); PG8_BAR;
    for (;;) {
        const bool has_next = S.next(ui + 1, nxt);
        const char* nA = has_next ? g.A + (GATHER ? (size_t)0 : S.a_off(nxt)) : cA; const char* nB = has_next ? g.Bt + S.b_off(nxt) : cB;
        if constexpr (GATHER) { if (has_next) { PG8_GATHER_V(nva0, nva1, nxt); } else {
#pragma unroll
            for (int i = 0; i < 2; ++i) { nva0[i] = cva0[i]; nva1[i] = cva1[i]; } } }
        for (int t = 0; t < nt; t += 2) {
            const bool last = (t == nt - 2);
            const char* a1 = cA + (size_t)(t + 1) * kstep;
            const char* a2 = last ? nA : cA + (size_t)(t + 2) * kstep; const char* b2 = last ? nB : cB + (size_t)(t + 2) * kstep;
            const char* a3 = a2 + kstep; const char* b3 = b2 + kstep;
            unsigned w0[2], w1[2];
#pragma unroll
            for (int i = 0; i < 2; ++i) { w0[i] = (GATHER && last) ? nva0[i] : cva0[i]; w1[i] = (GATHER && last) ? nva1[i] : cva1[i]; }
            PG8_LDB(B0, 0, 0); PG8_LDB(B1, 0, 1); PG8_SCHED; PG8_LDA(At, 0, 0); PG8_STAGE(PG8_SA(1, 1), a1, cva1);
            PG8_WAIT_V(8); PG8_WAIT_L(0); PG8_BAR; PG8_MMA(0, 0, At, B0); PG8_MMA(0, 1, At, B1); PG8_BAR; PG8_SCHED;
            PG8_LDA(At, 0, 1); PG8_STAGE(PG8_SB(0, 0), b2, voffB); PG8_STAGE(PG8_SB(0, 1), b2 + hstepB, voffB); PG8_STAGE(PG8_SA(0, 0), a2, w0);
            PG8_WAIT_V(8); PG8_WAIT_L(0); PG8_BAR; PG8_MMA(1, 0, At, B0); PG8_MMA(1, 1, At, B1); PG8_BAR; PG8_SCHED;
            PG8_LDB(B0, 1, 0); PG8_LDB(B1, 1, 1); PG8_SCHED; PG8_LDA(At, 1, 0); PG8_STAGE(PG8_SA(0, 1), a2, w1);
            PG8_WAIT_V(8); PG8_WAIT_L(0); PG8_BAR; PG8_MMA(0, 0, At, B0); PG8_MMA(0, 1, At, B1); PG8_BAR; PG8_SCHED;
            PG8_LDA(At, 1, 1); PG8_STAGE(PG8_SB(1, 0), b3, voffB); PG8_STAGE(PG8_SB(1, 1), b3 + hstepB, voffB); PG8_STAGE(PG8_SA(1, 0), a3, w0);
            PG8_WAIT_V(8); PG8_WAIT_L(0); PG8_BAR; PG8_MMA(1, 0, At, B0); PG8_MMA(1, 1, At, B1); PG8_BAR; PG8_SCHED;
        }
        if constexpr (ALIGN_EPI) { if (wr == 0) PG8_BAR; }
        E(acc, cur, wr, wc, fr, fq);
        if (!has_next) break;
#pragma unroll
        for (int a = 0; a < 2; ++a)
#pragma unroll
            for (int b = 0; b < 2; ++b)
#pragma unroll
                for (int m = 0; m < 4; ++m)
#pragma unroll
                    for (int n = 0; n < 2; ++n) acc[a][b][m][n] = (f32x4){0.f, 0.f, 0.f, 0.f};
        cur = nxt; cA = nA; cB = nB; ++ui;
        if constexpr (GATHER) {
#pragma unroll
            for (int i = 0; i < 2; ++i) { cva0[i] = nva0[i]; cva1[i] = nva1[i]; } }
        if constexpr (ALIGN_EPI) { if (wr == 1) PG8_BAR; }
    }
    PG8_WAIT_V(0);
    if constexpr (!ALIGN_EPI) { if (wr == 0) PG8_BAR; }
    PG8_BAR;
#undef PG8_SA
#undef PG8_SB
#undef PG8_STAGE
#undef PG8_LDA
#undef PG8_LDB
#undef PG8_MMA
#undef PG8_WAIT_V
#undef PG8_WAIT_L
#undef PG8_BAR
#undef PG8_SCHED
#undef PG8_GATHER_V
}
}
constexpr size_t MiB = 1u << 20;
constexpr size_t WS_CTL = 0, CTL_ZERO_BYTES = 1 * MiB;
constexpr size_t WS_MOD = 1 * MiB;
constexpr size_t WS_LIST = 2 * MiB;
constexpr size_t WS_CW = 5 * MiB;
constexpr size_t WS_KMS = 6 * MiB;
constexpr size_t WS_WQKV0 = 8 * MiB, WS_WO0 = 14 * MiB, WS_WKV1 = 16 * MiB, WS_WQ1 = 20 * MiB, WS_WO1 = 22 * MiB;
constexpr size_t WS_WGU = 24 * MiB;
constexpr size_t WS_WD2 = 56 * MiB;
constexpr size_t WS_A1 = 104 * MiB, WS_A2 = 168 * MiB, WS_A3 = 232 * MiB, WS_A4 = 296 * MiB, WS_A5 = 360 * MiB;
constexpr size_t WS_HID = 424 * MiB;
constexpr size_t WS_END = 464 * MiB;
constexpr int CW_BAR = 4096;
constexpr int CW_CNT = 64;

constexpr int RING_OFF = 0, RING_BYTES = 131072;
constexpr int LDSCTL_OFF = RING_BYTES, MISC_OFF = LDSCTL_OFF + 320;
constexpr int LDS_BYTES = 147456;

#define XB_TMO      128
#define XB_XCNT(j)  (256  + 64 * (j))
#define XB_XSUB(j)  (1280 + 64 * (j))
#define XB_XGEN(j)  (2304 + 64 * (j))
#define XB_TOP      3328
#define XB_TOPGEN   3392
#define XCD_BAR_WORDS 3456
#define XB_SPIN_CAP (1u << 18)
__device__ __forceinline__ unsigned xb_ld(unsigned* p)              { return __hip_atomic_load(p, __ATOMIC_RELAXED, __HIP_MEMORY_SCOPE_AGENT); }
__device__ __forceinline__ unsigned xb_add(unsigned* p, unsigned v) { return __hip_atomic_fetch_add(p, v, __ATOMIC_RELAXED, __HIP_MEMORY_SCOPE_AGENT); }
__device__ __forceinline__ unsigned xb_xcc_id() { return (unsigned)__builtin_amdgcn_s_getreg((3 << 11) | 20) & 0xFu; }
#define XB_SPIN(cond, bar) do { unsigned _sp = 0; while (cond) { __builtin_amdgcn_s_sleep(1); \
    if ((++_sp & 255u) == 0u) { if (xb_ld(&(bar)[XB_TMO])) break; if (_sp > XB_SPIN_CAP) { atomicAdd(&(bar)[XB_TMO], 1u); break; } } } } while (0)
struct XcdBarrier { unsigned* bar; unsigned x; volatile LAS unsigned* st; };
__device__ __forceinline__ XcdBarrier xcd_barrier_post(unsigned* bar, volatile LAS unsigned* st) {
    XcdBarrier b; b.bar = bar; b.x = xb_xcc_id(); b.st = st;
    if (threadIdx.x == 0) (void)xb_add(&bar[XB_XCNT(b.x)], 1u);
    return b;
}
__device__ __forceinline__ void xcd_barrier_complete(unsigned* bar, unsigned x, unsigned& nloc, unsigned& nx) {
    const unsigned G = gridDim.x * gridDim.y * gridDim.z;
    unsigned sum, cnt, mine, sp = 0u;
    for (;;) {
        sum = 0u; cnt = 0u; mine = 0u;
#pragma unroll
        for (unsigned j = 0; j < 16; ++j) { const unsigned c = xb_ld(&bar[XB_XCNT(j)]); sum += c; cnt += (c > 0u) ? 1u : 0u; mine = (j == x) ? c : mine; }
        if (sum == G) break;
        __builtin_amdgcn_s_sleep(1);
        if ((++sp & 255u) == 0u) { if (xb_ld(&bar[XB_TMO])) break; if (sp > XB_SPIN_CAP) { atomicAdd(&bar[XB_TMO], 1u); break; } }
    }
    nloc = mine > 0u ? mine : 1u; nx = cnt > 0u ? cnt : 1u;
}
__device__ __forceinline__ void xcd_barrier(const XcdBarrier& b) {
    asm volatile("s_waitcnt vmcnt(0)" ::: "memory");
    __syncthreads();
    if (threadIdx.x == 0) {
        unsigned* bar = b.bar;
        __builtin_amdgcn_s_waitcnt(0);
        unsigned nloc = b.st[0], nx = b.st[1];
        if (nloc == 0u) { xcd_barrier_complete(bar, b.x, nloc, nx); b.st[0] = nloc; b.st[1] = nx; }
        const unsigned old = xb_add(&bar[XB_XSUB(b.x)], 1u);
        const unsigned gen = old / nloc;
        if (old + 1u == (gen + 1u) * nloc) {
            __builtin_amdgcn_fence(__ATOMIC_RELEASE, "agent");
            asm volatile("s_waitcnt vmcnt(0)" ::: "memory");
            const unsigned og = xb_add(&bar[XB_TOP], 1u);
            const unsigned tg = og / nx;
            if (og + 1u == (tg + 1u) * nx) xb_add(&bar[XB_TOPGEN], 1u);
            else XB_SPIN(xb_ld(&bar[XB_TOPGEN]) == tg, bar);
            __builtin_amdgcn_fence(__ATOMIC_ACQUIRE, "agent");
            xb_add(&bar[XB_XGEN(b.x)], 1u);
            asm volatile("s_waitcnt vmcnt(0)" ::: "memory");
        } else {
            XB_SPIN(xb_ld(&bar[XB_XGEN(b.x)]) == gen, bar);
            __builtin_amdgcn_fence(__ATOMIC_ACQUIRE, "agent");
            asm volatile("s_waitcnt vmcnt(0)" ::: "memory");
        }
    }
    __syncthreads();
}

using pg8::Unit; using pg8::BM; using pg8::HALF;
struct EpiF16 {
    static constexpr bool PERM = true;
    f16* O; int ldc; int split_cols; size_t split_stride; int qcols; float qscale; int obf;
    __device__ __forceinline__ void operator()(const f32x4 (&acc)[2][2][4][2], const Unit& u, int wr, int wc, int fr, int fq) const {
        const int row0 = u.pm * BM + wr * 64 + fr; int colt = u.pn * BM; f16* base = O;
        const float sc = (colt < qcols) ? qscale : 1.f;
        if (split_cols) { const int t = colt / split_cols; base += (size_t)t * split_stride; colt -= t * split_cols; }
        const int col0 = colt + wc * 32 + 8 * fq;
#pragma unroll
        for (int ai = 0; ai < 2; ++ai)
#pragma unroll
            for (int m = 0; m < 4; ++m) { f16* rowp = base + (size_t)(row0 + ai * HALF + m * 16) * ldc + col0;
#pragma unroll
                for (int bj = 0; bj < 2; ++bj) { const f32x4 v0 = acc[ai][bj][m][0] * sc, v1 = acc[ai][bj][m][1] * sc;
                    u32x4 w; if (obf) { w.x = pkb(v0[0], v0[1]); w.y = pkb(v0[2], v0[3]); w.z = pkb(v1[0], v1[1]); w.w = pkb(v1[2], v1[3]); }
                    else { w.x = pkh(v0[0], v0[1]); w.y = pkh(v0[2], v0[3]); w.z = pkh(v1[0], v1[1]); w.w = pkh(v1[2], v1[3]); }
                    *(u32x4*)(rowp + bj * HALF) = w; } }
    }
};
struct EpiKV1 {
    static constexpr bool PERM = true;
    f16* O; int ldc; int split_cols; size_t split_stride; float* kms;
    __device__ __forceinline__ void operator()(const f32x4 (&acc)[2][2][4][2], const Unit& u, int wr, int wc, int fr, int fq) const {
        const int row0 = u.pm * BM + wr * 64 + fr; int colt = u.pn * BM; f16* base = O;
        const bool isk = colt < DM; const int kcol0 = colt + wc * 32 + 8 * fq;
        if (split_cols) { const int t = colt / split_cols; base += (size_t)t * split_stride; colt -= t * split_cols; }
        const int col0 = colt + wc * 32 + 8 * fq;
        f32x4 cs[2][2];
#pragma unroll
        for (int bj = 0; bj < 2; ++bj) { cs[bj][0] = (f32x4){0.f, 0.f, 0.f, 0.f}; cs[bj][1] = (f32x4){0.f, 0.f, 0.f, 0.f}; }
#pragma unroll
        for (int ai = 0; ai < 2; ++ai)
#pragma unroll
            for (int m = 0; m < 4; ++m) { f16* rowp = base + (size_t)(row0 + ai * HALF + m * 16) * ldc + col0;
#pragma unroll
                for (int bj = 0; bj < 2; ++bj) { const f32x4 v0 = acc[ai][bj][m][0], v1 = acc[ai][bj][m][1];
                    cs[bj][0] += v0; cs[bj][1] += v1;
                    u32x4 w; w.x = pkh(v0[0], v0[1]); w.y = pkh(v0[2], v0[3]); w.z = pkh(v1[0], v1[1]); w.w = pkh(v1[2], v1[3]);
                    *(u32x4*)(rowp + bj * HALF) = w; } }
        if (isk) {
#pragma unroll
            for (int bj = 0; bj < 2; ++bj)
#pragma unroll
                for (int n = 0; n < 2; ++n)
#pragma unroll
                    for (int e = 0; e < 4; ++e) { float s = cs[bj][n][e];
                        s += __shfl_xor(s, 1); s += __shfl_xor(s, 2); s += __shfl_xor(s, 4); s += __shfl_xor(s, 8);
                        if (fr == 0) atomicAdd(kms + (size_t)u.pm * DM + kcol0 + bj * HALF + 4 * n + e, s); }
        }
    }
};
struct EpiResid {
    static constexpr bool PERM = false;
    const float* base; float* out; const float* gate; int ldg;
    __device__ __forceinline__ void operator()(const f32x4 (&acc)[2][2][4][2], const Unit& u, int wr, int wc, int fr, int fq) const {
        const int b = (u.pm * BM) / SEQ; const int col0 = u.pn * BM + wc * 32 + 4 * fq;
        f32x4 gv[2][2];
#pragma unroll
        for (int bj = 0; bj < 2; ++bj)
#pragma unroll
            for (int n = 0; n < 2; ++n) { gv[bj][n] = *(const f32x4*)(gate + (size_t)b * ldg + col0 + bj * HALF + n * 16) + 1.0f; }
#pragma unroll
        for (int ai = 0; ai < 2; ++ai)
#pragma unroll
            for (int m = 0; m < 4; ++m) { const size_t off = (size_t)(u.pm * BM + ai * HALF + wr * 64 + m * 16 + fr) * DM + col0;
#pragma unroll
                for (int bj = 0; bj < 2; ++bj)
#pragma unroll
                    for (int n = 0; n < 2; ++n) { const f32x4 bs = *(const f32x4*)(base + off + bj * HALF + n * 16);
                        *(f32x4*)(out + off + bj * HALF + n * 16) = bs + gv[bj][n] * acc[ai][bj][m][n]; } }
    }
};


struct EpiQK {
    static constexpr bool PERM = true;
    f16* Qout; int qcols; float qscale; f16* Kf; float* kms;
    __device__ __forceinline__ void operator()(const f32x4 (&acc)[2][2][4][2], const Unit& u, int wr, int wc, int fr, int fq) const {
        const int row0 = u.pm * BM + wr * 64 + fr; const int colt = u.pn * BM;
        if (colt < qcols) {
            const int col0 = colt + wc * 32 + 8 * fq;
#pragma unroll
            for (int ai = 0; ai < 2; ++ai)
#pragma unroll
                for (int m = 0; m < 4; ++m) { f16* rowp = Qout + (size_t)(row0 + ai * HALF + m * 16) * DM + col0;
#pragma unroll
                    for (int bj = 0; bj < 2; ++bj) { const f32x4 v0 = acc[ai][bj][m][0] * qscale, v1 = acc[ai][bj][m][1] * qscale;
                        u32x4 w; w.x = pkh(v0[0], v0[1]); w.y = pkh(v0[2], v0[3]); w.z = pkh(v1[0], v1[1]); w.w = pkh(v1[2], v1[3]);
                        *(u32x4*)(rowp + bj * HALF) = w; } }
            return;
        }
        const int kc0 = colt - qcols + wc * 32 + 8 * fq;
        f32x4 cs[2][2];
#pragma unroll
        for (int bj = 0; bj < 2; ++bj) { cs[bj][0] = (f32x4){0.f, 0.f, 0.f, 0.f}; cs[bj][1] = (f32x4){0.f, 0.f, 0.f, 0.f}; }
#pragma unroll
        for (int ai = 0; ai < 2; ++ai)
#pragma unroll
            for (int m = 0; m < 4; ++m) { const int row = row0 + ai * HALF + m * 16; const int bb = row / SEQ, k = row % SEQ, T = k >> 5, r = k & 31;
#pragma unroll
                for (int bj = 0; bj < 2; ++bj) { const f32x4 v0 = acc[ai][bj][m][0], v1 = acc[ai][bj][m][1];
                    cs[bj][0] += v0; cs[bj][1] += v1;
                    const int kc = kc0 + bj * HALF, head = kc >> 6, d = kc & 63, s = d >> 4, hh = (d >> 3) & 1;
                    u32x4 w; w.x = pkh(v0[0], v0[1]); w.y = pkh(v0[2], v0[3]); w.z = pkh(v1[0], v1[1]); w.w = pkh(v1[2], v1[3]);
                    *(u32x4*)(Kf + ((((size_t)(bb * NH + head) * 256 + T) * 4 + s) * 64 + hh * 32 + r) * 8) = w; } }
        if (kms) {
#pragma unroll
            for (int bj = 0; bj < 2; ++bj)
#pragma unroll
                for (int n = 0; n < 2; ++n)
#pragma unroll
                    for (int e = 0; e < 4; ++e) { float s = cs[bj][n][e];
                        s += __shfl_xor(s, 1); s += __shfl_xor(s, 2); s += __shfl_xor(s, 4); s += __shfl_xor(s, 8);
                        if (fr == 0) atomicAdd(kms + (size_t)u.pm * DM + kc0 + bj * HALF + 4 * n + e, s); }
        }
    }
};
struct EpiVf {
    static constexpr bool PERM = true;
    unsigned short* Vf; int obf;
    __device__ __forceinline__ void operator()(const f32x4 (&acc)[2][2][4][2], const Unit& u, int wr, int wc, int fr, int fq) const {
#pragma unroll
        for (int ai = 0; ai < 2; ++ai)
#pragma unroll
            for (int m = 0; m < 4; ++m) { const int hd = u.pm * BM + ai * HALF + wr * 64 + m * 16 + fr; const int head = hd >> 6, d = hd & 63, d0 = d >> 5, r = d & 31;
#pragma unroll
                for (int bj = 0; bj < 2; ++bj) { const int t0 = u.pn * BM + bj * HALF + wc * 32 + 8 * fq; const int bb = t0 / SEQ, k = t0 % SEQ, T = k >> 5, kk = k & 31, sp = kk >> 4, j0 = ((kk & 15) >> 3) * 4;
                    const f32x4 v0 = acc[ai][bj][m][0], v1 = acc[ai][bj][m][1];
                    u32x2 w0, w1; if (obf) { w0.x = pkb(v0[0], v0[1]); w0.y = pkb(v0[2], v0[3]); w1.x = pkb(v1[0], v1[1]); w1.y = pkb(v1[2], v1[3]); }
                    else { w0.x = pkh(v0[0], v0[1]); w0.y = pkh(v0[2], v0[3]); w1.x = pkh(v1[0], v1[1]); w1.y = pkh(v1[2], v1[3]); }
                    unsigned short* p = Vf + (((((size_t)(bb * NH + head) * 256 + T) * 2 + d0) * 2 + sp) * 64 + r) * 8 + j0;
                    *(u32x2*)p = w0; *(u32x2*)(p + 32 * 8) = w1; } }
    }
};

struct MoeSched {
    const LAS int* tab; const int* list; int G, c, layer, stage;
    __device__ __forceinline__ bool next(int i, Unit& u) const {
        const int ntile = __builtin_amdgcn_readfirstlane(tab[24]); const long L = (long)i * G + c; if (L >= (long)ntile * 4) return false;
        const int tile = (int)(L >> 2), sub = (int)(L & 3);
        int cls = 0;
#pragma unroll 1
        for (int j = 1; j < NCLS; ++j) cls += (tab[j] <= tile) ? 1 : 0;
        cls = __builtin_amdgcn_readfirstlane(cls);
        u.pm = tile; u.pn = sub; u.cls = cls; u.tin = tile - __builtin_amdgcn_readfirstlane(tab[cls]); return true;
    }
    __device__ __forceinline__ size_t a_off(const Unit& u) const { return (size_t)u.pm * BM * 512 * 2; }
    __device__ __forceinline__ size_t b_off(const Unit& u) const {
        if (stage == 1) { const int g = u.cls / 6, p = u.cls % 6; const int a = p < 3 ? 0 : (p < 5 ? 1 : 2), bb = p < 3 ? p + 1 : (p < 5 ? p - 1 : 3);
            const int e = g * 4 + ((u.pn >> 1) ? bb : a); return ((size_t)(layer * NE + e) * 512 + (size_t)(u.pn & 1) * 256) * DM * 2; }
        return ((size_t)(layer * NCLS + u.cls) * DM + (size_t)u.pn * 256) * 512 * 2;
    }
    __device__ __forceinline__ int row_tok(const Unit& u, int r) const { int idx = u.tin * BM + r; const int cmax = tab[32 + u.cls] - 1; idx = idx < cmax ? idx : cmax; return list[u.cls * MT + idx]; }
};
struct EpiMoe1 {
    static constexpr bool PERM = true;
    f16* hid; const float* cw; MoeSched S;
    __device__ __forceinline__ void operator()(const f32x4 (&acc)[2][2][4][2], const Unit& u, int wr, int wc, int fr, int fq) const {
        const int k = u.pn >> 1, pnc = u.pn & 1; const int col0 = k * 256 + pnc * 128 + wc * 32 + 8 * fq;
#pragma unroll
        for (int ai = 0; ai < 2; ++ai)
#pragma unroll
            for (int m = 0; m < 4; ++m) { const int r = ai * HALF + wr * 64 + m * 16 + fr; const int tok = S.row_tok(u, r); const float cwv = cw[tok * 2 + k];
                float o[8];
#pragma unroll
                for (int n = 0; n < 2; ++n)
#pragma unroll
                    for (int e = 0; e < 4; ++e) { const float gg = acc[ai][0][m][n][e], uu = acc[ai][1][m][n][e];
                        const float sg = gg * __builtin_amdgcn_rcpf(1.f + __builtin_amdgcn_exp2f(-gg * LOG2E)); o[n * 4 + e] = sg * uu * cwv; }
                u32x4 w; w.x = pkh(o[0], o[1]); w.y = pkh(o[2], o[3]); w.z = pkh(o[4], o[5]); w.w = pkh(o[6], o[7]);
                *(u32x4*)(hid + (size_t)(u.pm * BM + r) * 512 + col0) = w; }
    }
};
struct EpiMoe2 {
    static constexpr bool PERM = false;
    float* x; const float* gate; int ldg; MoeSched S;
    __device__ __forceinline__ void operator()(const f32x4 (&acc)[2][2][4][2], const Unit& u, int wr, int wc, int fr, int fq) const {
        const int col0 = u.pn * BM + wc * 32 + 4 * fq; const int cnt = S.tab[32 + u.cls];
#pragma unroll
        for (int ai = 0; ai < 2; ++ai)
#pragma unroll
            for (int m = 0; m < 4; ++m) { const int r = ai * HALF + wr * 64 + m * 16 + fr; const int idx = u.tin * BM + r;
                if (idx < cnt) { const int tok = S.list[u.cls * MT + idx]; const int b = tok / SEQ; float* xr = x + (size_t)tok * DM + col0; const float* gr = gate + (size_t)b * ldg + col0;
#pragma unroll
                    for (int bj = 0; bj < 2; ++bj)
#pragma unroll
                        for (int n = 0; n < 2; ++n) { const f32x4 gv = *(const f32x4*)(gr + bj * HALF + n * 16) + 1.0f; const f32x4 bs = *(const f32x4*)(xr + bj * HALF + n * 16);
                            *(f32x4*)(xr + bj * HALF + n * 16) = bs + gv * acc[ai][bj][m][n]; } } }
    }
};
__device__ __forceinline__ void mod_item(const float* __restrict__ c, const float* __restrict__ W, const float* __restrict__ bias, float* out, int N, int n0, LAS float* red, int tid) {
    const int wave = tid >> 6, lane = tid & 63;
    float a0 = 0.f, a1 = 0.f, a2 = 0.f, a3 = 0.f;
    const float* wp = W + (size_t)(wave * 128) * N + n0 + lane;
    const float* cp = c + wave * 128;
#pragma unroll 16
    for (int k = 0; k < 128; ++k) { const float w = wp[(size_t)k * N]; a0 += cp[k] * w; a1 += cp[DM + k] * w; a2 += cp[2 * DM + k] * w; a3 += cp[3 * DM + k] * w; }
    red[(wave * 4 + 0) * 64 + lane] = a0; red[(wave * 4 + 1) * 64 + lane] = a1; red[(wave * 4 + 2) * 64 + lane] = a2; red[(wave * 4 + 3) * 64 + lane] = a3;
    __syncthreads();
    if (tid < 256) { const int b = tid >> 6, l = tid & 63; float s = bias[n0 + l];
#pragma unroll
        for (int w = 0; w < 8; ++w) s += red[(w * 4 + b) * 64 + l];
        out[(size_t)b * N + n0 + l] = s; }
    __syncthreads();
}
__device__ __forceinline__ void tr_item(const float* __restrict__ src, int ld_src, int k0, int n0, f16* dst, int ld_dst, int drow, int dk, LAS float* scr, int lane) {
#pragma unroll 8
    for (int i = 0; i < 32; ++i) { const int kk = 2 * i + (lane >> 5); scr[kk * 33 + (lane & 31)] = src[(size_t)(k0 + kk) * ld_src + n0 + (lane & 31)]; }
    asm volatile("s_waitcnt lgkmcnt(0)" ::: "memory");
    const int c = lane & 7;
#pragma unroll
    for (int j = 0; j < 4; ++j) { const int n = (lane >> 3) + 8 * j; const LAS float* s = scr + (8 * c) * 33 + n;
        u32x4 o; o.x = pkh(s[0 * 33], s[1 * 33]); o.y = pkh(s[2 * 33], s[3 * 33]); o.z = pkh(s[4 * 33], s[5 * 33]); o.w = pkh(s[6 * 33], s[7 * 33]);
        *(u32x4*)(dst + (size_t)(drow + n) * ld_dst + dk + k0 + 8 * c) = o; }
    asm volatile("s_waitcnt lgkmcnt(0)" ::: "memory");
}
struct Affine { f32x4 a[4], s[4]; };
__device__ __forceinline__ void load_affine(Affine& A, const float* __restrict__ g, const float* sc, const float* sh, int lane) {
#pragma unroll
    for (int j = 0; j < 4; ++j) { const int i = 4 * lane + 256 * j; const f32x4 gv = *(const f32x4*)(g + i), sv = *(const f32x4*)(sc + i); A.a[j] = gv * (sv + 1.0f); A.s[j] = *(const f32x4*)(sh + i); }
}
__device__ __forceinline__ void store_h(f16* orow, const f32x4 (&v)[4], float rs, const Affine& A, int lane) {
#pragma unroll
    for (int j = 0; j < 4; ++j) { const f32x4 h = v[j] * rs * A.a[j] + A.s[j]; u32x2 w; w.x = pkh(h[0], h[1]); w.y = pkh(h[2], h[3]); *(u32x2*)(orow + 4 * lane + 256 * j) = w; }
}
__device__ __forceinline__ float load_row(const float* xrow, f32x4 (&v)[4], int lane) {
    float s = 0.f;
#pragma unroll
    for (int j = 0; j < 4; ++j) { v[j] = *(const f32x4*)(xrow + 4 * lane + 256 * j); s += (v[j][0] * v[j][0] + v[j][1] * v[j][1]) + (v[j][2] * v[j][2] + v[j][3] * v[j][3]); }
    return __builtin_amdgcn_rsqf(wave_sum(s) * (1.f / DM) + EPS);
}

__device__ __forceinline__ void sb_naive_item(int idx, f16* Q, const f16* __restrict__ K, const f16* __restrict__ V) {
    const int t = idx % SEQ, h = (idx / SEQ) % NH, b = idx / (SEQ * NH);
    f16* qp = Q + (size_t)(b * SEQ + t) * DM + h * HD;
    f16 q[HD]; float o[HD];
#pragma unroll
    for (int d = 0; d < HD; ++d) { q[d] = qp[d]; o[d] = 0.f; }
    float R = 0.f;
    for (int s = t - 1; s >= 0; --s) {
        const f16* kp = K + (size_t)(b * SEQ + s) * DM + h * HD;
        float z = 0.f;
#pragma unroll
        for (int d = 0; d < HD; ++d) z += (float)q[d] * (float)kp[d];
        z = fminf(z, 126.f);
        const float L = log2f(1.f + exp2f(z));
        const float Cc = R + L;
        const float w = exp2f(z - Cc);
        const f16* vp = V + (size_t)(b * SEQ + s) * DM + h * HD;
#pragma unroll
        for (int d = 0; d < HD; ++d) o[d] += w * (float)vp[d];
        R = Cc;
        if (R > 152.f) break;
    }
#pragma unroll
    for (int d = 0; d < HD; ++d) qp[d] = (f16)o[d];
}
__device__ __forceinline__ void moba_naive_item(int idx, f16* Q, const f16* __restrict__ K, const f16* __restrict__ V, const float* __restrict__ kms) {
    const int t = idx % SEQ, h = (idx / SEQ) % NH, b = idx / (SEQ * NH);
    f16* qp = Q + (size_t)(b * SEQ + t) * DM + h * HD;
    f16 q[HD]; float o[HD];
#pragma unroll
    for (int d = 0; d < HD; ++d) { q[d] = qp[d]; o[d] = 0.f; }
    const int own = t / MBLK;
    float v0 = -INFINITY, v1 = -INFINITY, v2 = -INFINITY; int i0 = -1, i1 = -1, i2 = -1;
    for (int j = 0; j < own; ++j) {
        const float* kp = kms + (size_t)(b * NBLK + j) * DM + h * HD;
        float gsc = 0.f;
#pragma unroll
        for (int d = 0; d < HD; ++d) gsc += (float)q[d] * kp[d];
        if (gsc > v0) { v2 = v1; i2 = i1; v1 = v0; i1 = i0; v0 = gsc; i0 = j; }
        else if (gsc > v1) { v2 = v1; i2 = i1; v1 = gsc; i1 = j; }
        else if (gsc > v2) { v2 = gsc; i2 = j; }
    }
    const float slope2 = exp2f(-0.5f * (float)(h + 1)) * LOG2E;
    float m = -INFINITY, l = 0.f;
#pragma unroll
    for (int si = 0; si < 4; ++si) {
        const int j = si == 0 ? i0 : si == 1 ? i1 : si == 2 ? i2 : own;
        if (j < 0) continue;
        const int k_lo = j * MBLK, k_hi = (j == own) ? t : (k_lo + MBLK - 1);
        for (int s = k_lo; s <= k_hi; ++s) {
            const f16* kp = K + (size_t)(b * SEQ + s) * DM + h * HD;
            float z = 0.f;
#pragma unroll
            for (int d = 0; d < HD; ++d) z += (float)q[d] * (float)kp[d];
            z = z - slope2 * (float)(t - s);
            const float mn = fmaxf(m, z);
            const float al = exp2f(m - mn), p = exp2f(z - mn);
            l = l * al + p;
            const f16* vp = V + (size_t)(b * SEQ + s) * DM + h * HD;
#pragma unroll
            for (int d = 0; d < HD; ++d) o[d] = o[d] * al + p * (float)vp[d];
            m = mn;
        }
    }
    const float inv = 1.f / l;
#pragma unroll
    for (int d = 0; d < HD; ++d) qp[d] = (f16)(o[d] * inv);
}


__device__ __forceinline__ int crow16(int i, int h) { return (i & 3) + 8 * (i >> 2) + 4 * h; }
__device__ __forceinline__ f16x8 pack8(const f32x16& v, int s) {
    u32x4 p; p.x = pkh(v[8 * s + 0], v[8 * s + 1]); p.y = pkh(v[8 * s + 2], v[8 * s + 3]); p.z = pkh(v[8 * s + 4], v[8 * s + 5]); p.w = pkh(v[8 * s + 6], v[8 * s + 7]);
    return __builtin_bit_cast(f16x8, p);
}
__device__ __forceinline__ void sb_item(int item, const f16* __restrict__ Q, const f16* __restrict__ Kf, const f16* __restrict__ Vf, f16* O, int lane) {
    const int r = lane & 31, h = lane >> 5;
    const int qg = item & 255, head = (item >> 8) & 15, b = item >> 12;
    const int q0 = qg * 32;
    const f16* qrow = Q + (size_t)(b * SEQ + q0 + r) * DM + head * HD; f16* orow = O + (size_t)(b * SEQ + q0 + r) * DM + head * HD;
    f16x8 qf[4];
#pragma unroll
    for (int s = 0; s < 4; ++s) qf[s] = *(const f16x8*)(qrow + 16 * s + 8 * h);
    f16x8 tri[2], ones;
#pragma unroll
    for (int s = 0; s < 2; ++s)
#pragma unroll
        for (int j = 0; j < 8; ++j) { const int k = 16 * s + 8 * (j >> 2) + 4 * h + (j & 3); tri[s][j] = (k >= r) ? (f16)1.0f : (f16)0.0f; }
#pragma unroll
    for (int j = 0; j < 8; ++j) ones[j] = (f16)1.0f;
    f32x16 o0, o1;
#pragma unroll
    for (int i = 0; i < 16; ++i) { o0[i] = 0.f; o1[i] = 0.f; }
    float R = 0.f;
    const f16x8* kfb = (const f16x8*)Kf + (size_t)(b * NH + head) * 256 * 256 + lane;
    const f16x8* vfb = (const f16x8*)Vf + (size_t)(b * NH + head) * 256 * 256 + lane;
#define SB_LOAD(KF, VF, TT) do { const size_t t_ = (size_t)((TT) > 0 ? (TT) : 0) * 256; _Pragma("unroll") for (int s = 0; s < 4; ++s) { KF[s] = kfb[t_ + s * 64]; VF[s] = vfb[t_ + s * 64]; } } while (0)
#define SB_TILE(KF, VF, TT) do { \
        f32x16 x; _Pragma("unroll") for (int i = 0; i < 16; ++i) x[i] = 0.f; \
        _Pragma("unroll") for (int s = 0; s < 4; ++s) x = __builtin_amdgcn_mfma_f32_32x32x16_f16(KF[s], qf[s], x, 0, 0, 0); \
        const bool diag = ((TT) == qg); \
        f32x16 L; \
        _Pragma("unroll") for (int i = 0; i < 16; ++i) { const float z = __builtin_fminf(x[i], 126.f); x[i] = z; L[i] = __builtin_amdgcn_logf(1.f + __builtin_amdgcn_exp2f(z)); } \
        if (diag) { _Pragma("unroll") for (int i = 0; i < 16; ++i) if (crow16(i, h) >= r) L[i] = 0.f; } \
        const f16x8 lb0 = pack8(L, 0), lb1 = pack8(L, 1); \
        f32x16 y, tt; _Pragma("unroll") for (int i = 0; i < 16; ++i) { y[i] = R; tt[i] = 0.f; } \
        y = __builtin_amdgcn_mfma_f32_32x32x16_f16(tri[0], lb0, y, 0, 0, 0); y = __builtin_amdgcn_mfma_f32_32x32x16_f16(tri[1], lb1, y, 0, 0, 0); \
        tt = __builtin_amdgcn_mfma_f32_32x32x16_f16(ones, lb0, tt, 0, 0, 0); tt = __builtin_amdgcn_mfma_f32_32x32x16_f16(ones, lb1, tt, 0, 0, 0); \
        f32x16 w; _Pragma("unroll") for (int i = 0; i < 16; ++i) w[i] = __builtin_amdgcn_exp2f(x[i] - y[i]); \
        if (diag) { _Pragma("unroll") for (int i = 0; i < 16; ++i) if (crow16(i, h) >= r) w[i] = 0.f; } \
        R += tt[0]; \
        const f16x8 pb0 = pack8(w, 0), pb1 = pack8(w, 1); \
        o0 = __builtin_amdgcn_mfma_f32_32x32x16_f16(VF[0], pb0, o0, 0, 0, 0); o0 = __builtin_amdgcn_mfma_f32_32x32x16_f16(VF[1], pb1, o0, 0, 0, 0); \
        o1 = __builtin_amdgcn_mfma_f32_32x32x16_f16(VF[2], pb0, o1, 0, 0, 0); o1 = __builtin_amdgcn_mfma_f32_32x32x16_f16(VF[3], pb1, o1, 0, 0, 0); } while (0)
    f16x8 kA[4], vA[4], kB[4], vB[4];
    SB_LOAD(kA, vA, qg);
#pragma unroll 1
    for (int T = qg; T >= 0; T -= 2) {
        SB_LOAD(kB, vB, T - 1);
        __builtin_amdgcn_sched_barrier(0);
        SB_TILE(kA, vA, T);
        if (T == 0 || __all(R >= 152.f)) break;
        SB_LOAD(kA, vA, T - 2);
        __builtin_amdgcn_sched_barrier(0);
        SB_TILE(kB, vB, T - 1);
        if (__all(R >= 152.f)) break;
    }
#undef SB_LOAD
#undef SB_TILE
#pragma unroll
    for (int g = 0; g < 4; ++g) {
        u32x2 w0, w1; w0.x = pkh(o0[4 * g], o0[4 * g + 1]); w0.y = pkh(o0[4 * g + 2], o0[4 * g + 3]); w1.x = pkh(o1[4 * g], o1[4 * g + 1]); w1.y = pkh(o1[4 * g + 2], o1[4 * g + 3]);
        *(u32x2*)(orow + 8 * g + 4 * h) = w0; *(u32x2*)(orow + 32 + 8 * g + 4 * h) = w1;
    }
}

typedef __bf16 bf16x2 __attribute__((ext_vector_type(2)));
typedef __bf16 bf16x4 __attribute__((ext_vector_type(4)));
typedef __bf16 bf16x8 __attribute__((ext_vector_type(8)));
__device__ __forceinline__ bf16x8 pack8b(const f32x16& v, int s) {
    u32x4 p; p.x = pkb(v[8 * s + 0], v[8 * s + 1]); p.y = pkb(v[8 * s + 2], v[8 * s + 3]); p.z = pkb(v[8 * s + 4], v[8 * s + 5]); p.w = pkb(v[8 * s + 6], v[8 * s + 7]);
    return __builtin_bit_cast(bf16x8, p);
}
constexpr int MB_SL = 0;
constexpr int MB_SLP = 136;
constexpr int MB_SLL = 768 * MB_SLP;
constexpr int MB_M = MB_SLL + 3072;
constexpr int MB_CNT = MB_M + 1024;
constexpr int MB_LST = MB_CNT + 128;
constexpr int MB_END = MB_LST + 16384;
static_assert(MB_END <= RING_BYTES, "MoBA LDS map");
#define TOP3_INSERT(v, ix) do { const float v_ = (v); const int i_ = (ix); \
        if (v_ > t0) { t2 = t1; j2 = j1; t1 = t0; j1 = j0; t0 = v_; j0 = i_; } else if (v_ > t1) { t2 = t1; j2 = j1; t1 = v_; j1 = i_; } else if (v_ > t2) { t2 = v_; j2 = i_; } } while (0)
__device__ __forceinline__ void moba_unit(int b, int head, int blk, const f16* __restrict__ Q, f16* O, const f16* __restrict__ Kf, const __bf16* __restrict__ Vf, const float* __restrict__ kms, LAS unsigned char* lds, int tid) {
    const int lane = tid & 63, wave = __builtin_amdgcn_readfirstlane(tid >> 6), r = lane & 31, h = lane >> 5;
    LAS unsigned char* slots = lds + MB_SL; LAS float* sll = (LAS float*)(lds + MB_SLL); LAS float* mref = (LAS float*)(lds + MB_M);
    LAS int* cnt = (LAS int*)(lds + MB_CNT); LAS unsigned short* qlist = (LAS unsigned short*)(lds + MB_LST);
    const float slope2 = __builtin_amdgcn_exp2f(-0.5f * (float)(head + 1)) * LOG2E;
    const size_t tok0 = (size_t)b * SEQ + (size_t)blk * MBLK;
    const f16x8* kfb = (const f16x8*)Kf + (size_t)(b * NH + head) * 256 * 256 + lane;
    const bf16x8* vfb = (const bf16x8*)Vf + (size_t)(b * NH + head) * 256 * 256 + lane;
    if (tid < 32) cnt[tid] = 0;
    __syncthreads();
    const int qlw = wave * 32 + r;
#define MB_LOAD(KF, VF, TT) do { const size_t t_ = (size_t)(TT) * 256; _Pragma("unroll") for (int s = 0; s < 4; ++s) { KF[s] = kfb[t_ + s * 64]; VF[s] = vfb[t_ + s * 64]; } } while (0)
    {
        const f16* qrow = Q + (tok0 + qlw) * DM + head * HD;
        f16x8 qf[4];
#pragma unroll
        for (int s = 0; s < 4; ++s) qf[s] = *(const f16x8*)(qrow + 16 * s + 8 * h);
        f16x8 kd[4];
#pragma unroll
        for (int s = 0; s < 4; ++s) kd[s] = kfb[((size_t)blk * 8 + wave) * 256 + s * 64];
        f32x16 g;
#pragma unroll
        for (int i = 0; i < 16; ++i) g[i] = 0.f;
#pragma unroll
        for (int s = 0; s < 4; ++s) { const float* kp = kms + (size_t)(b * NBLK + r) * DM + head * HD + 16 * s + 8 * h;
            const f32x4 a0 = *(const f32x4*)kp * (1.f / MBLK), a1 = *(const f32x4*)(kp + 4) * (1.f / MBLK);
            u32x4 p; p.x = pkh(a0[0], a0[1]); p.y = pkh(a0[2], a0[3]); p.z = pkh(a1[0], a1[1]); p.w = pkh(a1[2], a1[3]);
            g = __builtin_amdgcn_mfma_f32_32x32x16_f16(__builtin_bit_cast(f16x8, p), qf[s], g, 0, 0, 0); }
        float t0 = -INFINITY, t1 = -INFINITY, t2 = -INFINITY; int j0 = -1, j1 = -1, j2 = -1;
#pragma unroll
        for (int i = 0; i < 16; ++i) { const int jb = crow16(i, h); if (jb < blk) TOP3_INSERT(g[i], jb); }
        { const float p0 = __shfl_xor(t0, 32), p1 = __shfl_xor(t1, 32), p2 = __shfl_xor(t2, 32); const int q0_ = __shfl_xor(j0, 32), q1_ = __shfl_xor(j1, 32), q2_ = __shfl_xor(j2, 32);
          TOP3_INSERT(p0, q0_); TOP3_INSERT(p1, q1_); TOP3_INSERT(p2, q2_); }
        if (h == 0) {
            if (j0 >= 0) { const int sl = __hip_atomic_fetch_add(cnt + j0, 1, __ATOMIC_RELAXED, __HIP_MEMORY_SCOPE_WORKGROUP); qlist[j0 * 256 + sl] = (unsigned short)qlw; }
            if (j1 >= 0) { const int sl = __hip_atomic_fetch_add(cnt + j1, 1, __ATOMIC_RELAXED, __HIP_MEMORY_SCOPE_WORKGROUP); qlist[j1 * 256 + sl] = (unsigned short)(qlw | 256); }
            if (j2 >= 0) { const int sl = __hip_atomic_fetch_add(cnt + j2, 1, __ATOMIC_RELAXED, __HIP_MEMORY_SCOPE_WORKGROUP); qlist[j2 * 256 + sl] = (unsigned short)(qlw | 512); }
        }
        f32x16 x;
#pragma unroll
        for (int i = 0; i < 16; ++i) x[i] = 0.f;
#pragma unroll
        for (int s = 0; s < 4; ++s) x = __builtin_amdgcn_mfma_f32_32x32x16_f16(kd[s], qf[s], x, 0, 0, 0);
        float sd = -INFINITY;
#pragma unroll
        for (int i = 0; i < 16; ++i) sd = (crow16(i, h) == r) ? x[i] : sd;
        sd = __builtin_fmaxf(sd, __shfl_xor(sd, 32));
        if (h == 0) mref[qlw] = sd;
    }
    __syncthreads();
    {
        int total = 0;
        for (int j = 0; j < blk; ++j) total += (cnt[j] + 31) >> 5;
        total = __builtin_amdgcn_readfirstlane(total);
#pragma unroll 1
        for (int n = wave; n < total; n += NWAVES) {
            int j = 0, accg = 0;
            for (;; ++j) { const int ng = (cnt[j] + 31) >> 5; if (n < accg + ng) break; accg += ng; }
            j = __builtin_amdgcn_readfirstlane(j); const int grp = n - __builtin_amdgcn_readfirstlane(accg);
            const int cj = __builtin_amdgcn_readfirstlane(cnt[j]);
            const int li = grp * 32 + r; const bool valid = li < cj;
            const int ent = qlist[j * 256 + (valid ? li : 0)]; const int ql = ent & 255, rank = ent >> 8;
            const f16* qrow = Q + (tok0 + ql) * DM + head * HD;
            f16x8 qf[4];
#pragma unroll
            for (int s = 0; s < 4; ++s) qf[s] = *(const f16x8*)(qrow + 16 * s + 8 * h);
            const float mr = mref[ql];
            const float cb = slope2 * (float)(256 * (j - blk) - ql) - mr;
            f32x16 p0, p1;
#pragma unroll
            for (int i = 0; i < 16; ++i) { p0[i] = 0.f; p1[i] = 0.f; }
            float ps = 0.f;
#define MB_TILE(KF, VF, KT) do { \
                f32x16 x; _Pragma("unroll") for (int i = 0; i < 16; ++i) x[i] = slope2 * (float)(32 * (KT) + crow16(i, h)) + cb; \
                _Pragma("unroll") for (int s = 0; s < 4; ++s) x = __builtin_amdgcn_mfma_f32_32x32x16_f16(KF[s], qf[s], x, 0, 0, 0); \
                _Pragma("unroll") for (int i = 0; i < 16; ++i) { x[i] = __builtin_amdgcn_exp2f(x[i]); ps += x[i]; } \
                const bf16x8 pb0 = pack8b(x, 0), pb1 = pack8b(x, 1); \
                p0 = __builtin_amdgcn_mfma_f32_32x32x16_bf16(VF[0], pb0, p0, 0, 0, 0); p0 = __builtin_amdgcn_mfma_f32_32x32x16_bf16(VF[1], pb1, p0, 0, 0, 0); \
                p1 = __builtin_amdgcn_mfma_f32_32x32x16_bf16(VF[2], pb0, p1, 0, 0, 0); p1 = __builtin_amdgcn_mfma_f32_32x32x16_bf16(VF[3], pb1, p1, 0, 0, 0); } while (0)
            f16x8 kA[4], kB[4]; bf16x8 vA[4], vB[4];
            const size_t T0 = (size_t)j * 8;
            MB_LOAD(kA, vA, T0);
#pragma unroll 1
            for (int kt = 0; kt < 8; kt += 2) {
                MB_LOAD(kB, vB, T0 + kt + 1);
                __builtin_amdgcn_sched_barrier(0);
                MB_TILE(kA, vA, kt);
                MB_LOAD(kA, vA, T0 + (kt + 2 < 8 ? kt + 2 : 7));
                __builtin_amdgcn_sched_barrier(0);
                MB_TILE(kB, vB, kt + 1);
            }
#undef MB_TILE
            if (valid) {
                LAS unsigned char* sp = slots + (ql * 3 + rank) * MB_SLP + 8 * h;
#pragma unroll
                for (int g4 = 0; g4 < 4; ++g4) { u32x2 w0, w1; w0.x = pkb(p0[4 * g4], p0[4 * g4 + 1]); w0.y = pkb(p0[4 * g4 + 2], p0[4 * g4 + 3]); w1.x = pkb(p1[4 * g4], p1[4 * g4 + 1]); w1.y = pkb(p1[4 * g4 + 2], p1[4 * g4 + 3]);
                    *(LAS u32x2*)(sp + 16 * g4) = w0; *(LAS u32x2*)(sp + 64 + 16 * g4) = w1; }
                const float pst = ps + __shfl_xor(ps, 32);
                if (h == 0) sll[ql * 3 + rank] = pst;
            }
        }
    }
    __syncthreads();
    {
        const f16* qrow = Q + (tok0 + qlw) * DM + head * HD;
        f16x8 qf[4];
#pragma unroll
        for (int s = 0; s < 4; ++s) qf[s] = *(const f16x8*)(qrow + 16 * s + 8 * h);
        f32x16 o0, o1; float m = -1e30f, l = 0.f;
#pragma unroll
        for (int i = 0; i < 16; ++i) { o0[i] = 0.f; o1[i] = 0.f; }
#define MB_OWN(KF, VF, KT) do { \
            f32x16 x; _Pragma("unroll") for (int i = 0; i < 16; ++i) x[i] = slope2 * (float)(32 * (KT) + crow16(i, h) - qlw); \
            _Pragma("unroll") for (int s = 0; s < 4; ++s) x = __builtin_amdgcn_mfma_f32_32x32x16_f16(KF[s], qf[s], x, 0, 0, 0); \
            if ((KT) == wave) { _Pragma("unroll") for (int i = 0; i < 16; ++i) if (crow16(i, h) > r) x[i] = -INFINITY; } \
            float tm = x[0]; _Pragma("unroll") for (int i = 1; i < 16; ++i) tm = __builtin_fmaxf(tm, x[i]); \
            tm = __builtin_fmaxf(tm, __shfl_xor(tm, 32)); \
            const float mn = __builtin_fmaxf(m, tm); const float al = __builtin_amdgcn_exp2f(m - mn); m = mn; \
            float ps = 0.f; _Pragma("unroll") for (int i = 0; i < 16; ++i) { x[i] = __builtin_amdgcn_exp2f(x[i] - mn); ps += x[i]; } \
            l = l * al + ps; \
            _Pragma("unroll") for (int i = 0; i < 16; ++i) { o0[i] *= al; o1[i] *= al; } \
            const bf16x8 pb0 = pack8b(x, 0), pb1 = pack8b(x, 1); \
            o0 = __builtin_amdgcn_mfma_f32_32x32x16_bf16(VF[0], pb0, o0, 0, 0, 0); o0 = __builtin_amdgcn_mfma_f32_32x32x16_bf16(VF[1], pb1, o0, 0, 0, 0); \
            o1 = __builtin_amdgcn_mfma_f32_32x32x16_bf16(VF[2], pb0, o1, 0, 0, 0); o1 = __builtin_amdgcn_mfma_f32_32x32x16_bf16(VF[3], pb1, o1, 0, 0, 0); } while (0)
        {
            f16x8 kA[4], kB[4]; bf16x8 vA[4], vB[4];
            const size_t T0 = (size_t)blk * 8;
            MB_LOAD(kA, vA, T0);
#pragma unroll 1
            for (int kt = 0; kt <= wave; kt += 2) {
                MB_LOAD(kB, vB, T0 + (kt + 1 <= wave ? kt + 1 : wave));
                __builtin_amdgcn_sched_barrier(0);
                MB_OWN(kA, vA, kt);
                if (kt + 1 > wave) break;
                MB_LOAD(kA, vA, T0 + (kt + 2 <= wave ? kt + 2 : wave));
                __builtin_amdgcn_sched_barrier(0);
                MB_OWN(kB, vB, kt + 1);
            }
        }
#undef MB_OWN
        const float fsc = __builtin_amdgcn_exp2f(m - mref[qlw]);
        float lt = (l + __shfl_xor(l, 32)) * fsc;
#pragma unroll
        for (int i = 0; i < 16; ++i) { o0[i] *= fsc; o1[i] *= fsc; }
        const int nsel = blk < 3 ? blk : 3;
        for (int rk = 0; rk < nsel; ++rk) {
            const LAS unsigned char* sp = slots + (qlw * 3 + rk) * MB_SLP + 8 * h;
            lt += sll[qlw * 3 + rk];
#pragma unroll
            for (int g4 = 0; g4 < 4; ++g4) { const u32x2 w0 = *(const LAS u32x2*)(sp + 16 * g4), w1 = *(const LAS u32x2*)(sp + 64 + 16 * g4);
                o0[4 * g4] += __uint_as_float(w0.x << 16); o0[4 * g4 + 1] += __uint_as_float(w0.x & 0xffff0000u); o0[4 * g4 + 2] += __uint_as_float(w0.y << 16); o0[4 * g4 + 3] += __uint_as_float(w0.y & 0xffff0000u);
                o1[4 * g4] += __uint_as_float(w1.x << 16); o1[4 * g4 + 1] += __uint_as_float(w1.x & 0xffff0000u); o1[4 * g4 + 2] += __uint_as_float(w1.y << 16); o1[4 * g4 + 3] += __uint_as_float(w1.y & 0xffff0000u); }
        }
        const float inv = 1.f / lt;
        f16* orow = O + (tok0 + qlw) * DM + head * HD;
#pragma unroll
        for (int g4 = 0; g4 < 4; ++g4) {
            u32x2 w0, w1; w0.x = pkh(o0[4 * g4] * inv, o0[4 * g4 + 1] * inv); w0.y = pkh(o0[4 * g4 + 2] * inv, o0[4 * g4 + 3] * inv);
            w1.x = pkh(o1[4 * g4] * inv, o1[4 * g4 + 1] * inv); w1.y = pkh(o1[4 * g4 + 2] * inv, o1[4 * g4 + 3] * inv);
            *(u32x2*)(orow + 8 * g4 + 4 * h) = w0; *(u32x2*)(orow + 32 + 8 * g4 + 4 * h) = w1;
        }
    }
#undef MB_LOAD
    __syncthreads();
}

constexpr int N_PHASES = 16;
struct Args { const float* in[22]; float* out; unsigned char* ws; int ph_lo, ph_hi, bar_region, pad; };
__global__ void __launch_bounds__(NTHREADS, 2) mk_fwd(Args args) {
    extern __shared__ __attribute__((aligned(16))) unsigned char lds_raw[];
    LAS unsigned char* lds = (LAS unsigned char*)lds_raw;
    volatile LAS unsigned* MISC = (volatile LAS unsigned*)(lds + MISC_OFF);
    const int tid = threadIdx.x, lane = tid & 63, wave = __builtin_amdgcn_readfirstlane(tid >> 6);
    const int G = gridDim.x; const int bx = blockIdx.x; const int vcu = (G % 8 == 0) ? (bx % 8) * (G / 8) + bx / 8 : bx;
    const int gw = vcu * NWAVES + wave, NGW = G * NWAVES;
    unsigned char* ws = args.ws;
    unsigned* ctl = (unsigned*)(ws + WS_CTL);
    const float* x = args.in[0];      const float* c = args.in[1];
    const float* w_ada = args.in[2];  const float* b_ada = args.in[3];
    const float* g_attn = args.in[4]; const float* g_ffn = args.in[5];
    const float* w_qkv_a = args.in[6]; const float* w_o_a = args.in[7];
    const float* w_ada_kv = args.in[8]; const float* b_ada_kv = args.in[9];
    const float* g_kv = args.in[10];  const float* w_kv = args.in[11];
    const float* w_q_b = args.in[12]; const float* w_o_b = args.in[13];
    const float* w_rg = args.in[14];  const float* b_rg = args.in[15];
    const float* w_re = args.in[16];  const float* b_re = args.in[17];
    const float* w_gate = args.in[18]; const float* w_up = args.in[19];
    const float* w_down = args.in[20]; const float* g_final = args.in[21];
    float* out = args.out;
    float* mod = (float*)(ws + WS_MOD); float* modkv = mod + 2 * 4 * 6144;
    int* list = (int*)(ws + WS_LIST); float* cw = (float*)(ws + WS_CW); float* kms = (float*)(ws + WS_KMS);
    f16* Wqkv0 = (f16*)(ws + WS_WQKV0); f16* Wo0 = (f16*)(ws + WS_WO0); f16* Wkv1 = (f16*)(ws + WS_WKV1); f16* Wq1 = (f16*)(ws + WS_WQ1); f16* Wo1 = (f16*)(ws + WS_WO1);
    f16* Wgu = (f16*)(ws + WS_WGU); f16* Wd2 = (f16*)(ws + WS_WD2);
    f16* A1 = (f16*)(ws + WS_A1); f16* A2 = (f16*)(ws + WS_A2); f16* A3 = (f16*)(ws + WS_A3); f16* A4 = (f16*)(ws + WS_A4); f16* A5 = (f16*)(ws + WS_A5); f16* HID = (f16*)(ws + WS_HID);
    int* ccnt = (int*)(ctl + CW_CNT);

    for (int u = tid; u < (LDS_BYTES - LDSCTL_OFF) / 4; u += NTHREADS) ((LAS unsigned*)(lds + LDSCTL_OFF))[u] = 0u;
    __syncthreads();
    const bool use_bar = (args.ph_hi - args.ph_lo) > 1;
    XcdBarrier bar; bar.bar = ctl + CW_BAR + args.bar_region * XCD_BAR_WORDS; bar.x = 0; bar.st = nullptr;
    if (use_bar) bar = xcd_barrier_post(ctl + CW_BAR + args.bar_region * XCD_BAR_WORDS, MISC + 8);
    const int lo = args.ph_lo, hi = args.ph_hi;
#define IN(k) (lo <= (k) && (k) < hi)
#define SEAM(k) do { if (IN(k) && IN((k) + 1)) xcd_barrier(bar); } while (0)
#ifndef MK_RPT_PHASE
#define MK_RPT_PHASE -1
#define MK_RPT_N 1
#endif
#ifndef MK_DBG
#define MK_DBG 0
#endif
#define RPT(k) (((k) == MK_RPT_PHASE) ? MK_RPT_N : 1)

    if (IN(0)) for (int rep_ = 0; rep_ < RPT(0); ++rep_) { if (rep_) xcd_barrier(bar);
        for (int i = gw * 64 + lane; i < NB * NBLK * DM; i += NGW * 64) kms[i] = 0.f;
        {
            LAS float* red = (LAS float*)lds;
            for (int it = vcu; it < 224; it += G) {
                if (it < 96) mod_item(c, w_ada, b_ada, mod, 6144, it * 64, red, tid);
                else if (it < 192) mod_item(c, w_ada + (size_t)DM * 6144, b_ada + 6144, mod + 4 * 6144, 6144, (it - 96) * 64, red, tid);
                else mod_item(c, w_ada_kv, b_ada_kv, modkv, 2048, (it - 192) * 64, red, tid);
            }
        }
        LAS float* scr = (LAS float*)(lds + 16384 + wave * 12288);
        for (int it = gw; it < 24576; it += NGW) {
            if (it < 1536) { tr_item(w_qkv_a, 3072, 64 * (it / 96), 32 * (it % 96), Wqkv0, DM, 32 * (it % 96), 0, scr, lane); continue; }
            if (it < 2048) { const int r = it - 1536; tr_item(w_o_a, DM, 64 * (r / 32), 32 * (r % 32), Wo0, DM, 32 * (r % 32), 0, scr, lane); continue; }
            if (it < 3072) { const int r = it - 2048; tr_item(w_kv, 2048, 64 * (r / 64), 32 * (r % 64), Wkv1, DM, 32 * (r % 64), 0, scr, lane); continue; }
            if (it < 3584) { const int r = it - 3072; tr_item(w_q_b, DM, 64 * (r / 32), 32 * (r % 32), Wq1, DM, 32 * (r % 32), 0, scr, lane); continue; }
            if (it < 4096) { const int r = it - 3584; tr_item(w_o_b, DM, 64 * (r / 32), 32 * (r % 32), Wo1, DM, 32 * (r % 32), 0, scr, lane); continue; }
            if (it < 12288) { const int r = it - 4096, mat = r >> 7, sub = r & 127; const int le = mat >> 1, which = mat & 1, kb = sub >> 3, nb = sub & 7;
                const float* src = (which ? w_up : w_gate) + (size_t)le * DM * EFF; const int n0 = 32 * nb;
                tr_item(src, EFF, 64 * kb, n0, Wgu + (size_t)le * 512 * DM, DM, 256 * (n0 >> 7) + 128 * which + (n0 & 127), 0, scr, lane); continue; }
            { const int r = it - 12288, mat = r >> 7, sub = r & 127; const int lc = mat >> 1, side = mat & 1, kb = sub >> 5, nb = sub & 31;
                const int layer = lc / NCLS, cls = lc % NCLS, gq = cls / 6, p = cls % 6; const int a = p < 3 ? 0 : (p < 5 ? 1 : 2), bb = p < 3 ? p + 1 : (p < 5 ? p - 1 : 3);
                const int e = gq * 4 + (side ? bb : a);
                tr_item(w_down + (size_t)(layer * NE + e) * EFF * DM, DM, 64 * kb, 32 * nb, Wd2 + (size_t)lc * DM * 512, 512, 32 * nb, 256 * side, scr, lane); }
        }
    }
    SEAM(0);
    if (IN(1)) for (int rep_ = 0; rep_ < RPT(1); ++rep_) { if (rep_) xcd_barrier(bar);
        for (int ch = gw; ch < MT / 16; ch += NGW) {
        const int row0 = ch * 16, b = row0 / SEQ; Affine A; load_affine(A, g_attn, mod + (size_t)b * 6144 + 1024, mod + (size_t)b * 6144, lane);
        for (int r = row0; r < row0 + 16; ++r) { f32x4 v[4]; const float rs = load_row(x + (size_t)r * DM, v, lane); store_h(A1 + (size_t)r * DM, v, rs, A, lane); } }
    }
    SEAM(1);
    if (IN(2)) for (int rep_ = 0; rep_ < RPT(2); ++rep_) { if (rep_) xcd_barrier(bar);
        { pg8::Gemm g{(const char*)A1, (const char*)Wqkv0, DM, DM, DM}; pg8::StaticOrder S; S.init(MT, 2048, G, bx, DM, DM);
          EpiQK E{A3, DM, QSCALE, A4, nullptr};
          pg8::gemm_phase<EpiQK, pg8::StaticOrder, true, false>(lds + RING_OFF, g, S, E); }
        { pg8::Gemm g{(const char*)(Wqkv0 + (size_t)2048 * DM), (const char*)A1, DM, DM, DM}; pg8::StaticOrder S; S.init(DM, MT, G, bx, DM, DM);
          EpiVf E{(unsigned short*)A5, 0};
          pg8::gemm_phase<EpiVf, pg8::StaticOrder, true, false>(lds + RING_OFF, g, S, E); }
    }
    SEAM(2);
    if (IN(3)) for (int rep_ = 0; rep_ < RPT(3); ++rep_) { if (rep_) xcd_barrier(bar); for (int item = gw; item < NB * NH * (SEQ / 32); item += NGW) sb_item(item, A3, A4, A5, A2, lane); }
    SEAM(3);
    if (IN(4)) for (int rep_ = 0; rep_ < RPT(4); ++rep_) { if (rep_) xcd_barrier(bar);
        pg8::Gemm g{(const char*)A2, (const char*)Wo0, DM, DM, DM}; pg8::StaticOrder S; S.init(MT, DM, G, bx, DM, DM);
        EpiResid E{x, out, mod + 2048, 6144};
        pg8::gemm_phase<EpiResid, pg8::StaticOrder, true, false>(lds + RING_OFF, g, S, E);
    }
    SEAM(4);
#define ROUTER_PHASE(LAYER) do { \
        LAS float* wl = (LAS float*)lds; \
        LAS int* rl_cnt = (LAS int*)(lds + 90112); LAS int* rl_base = rl_cnt + 32; LAS int* rl_tok = rl_cnt + 64; LAS int* rl_cls = rl_cnt + 192; LAS int* rl_slot = rl_cnt + 320; \
        LAS float* rl_lo = (LAS float*)(rl_cnt + 448); LAS float* rl_hi = (LAS float*)(rl_cnt + 576); \
        if (tid < NCLS) rl_cnt[tid] = 0; \
        const float* wrg = w_rg + (LAYER) * DM * 4; const float* wre = w_re + (LAYER) * DM * 16; \
        for (int idx = tid; idx < DM * 20; idx += NTHREADS) { const int k = idx / 20, o = idx % 20; const int j = k >> 8, rem = k & 255, l = rem >> 2, e = rem & 3; \
            wl[(j * 64 + l) * 84 + e * 20 + o] = o < 4 ? wrg[k * 4 + o] : wre[k * 16 + o - 4]; } \
        __syncthreads(); \
        const float* md = mod + (size_t)(LAYER) * 4 * 6144; \
        for (int ch = gw; ch < MT / 16; ch += NGW) { \
        const int row0 = ch * 16, b = row0 / SEQ; Affine A; load_affine(A, g_ffn + (LAYER) * DM, md + (size_t)b * 6144 + 4096, md + (size_t)b * 6144 + 3072, lane); \
        float brg[4], bre[16]; \
        _Pragma("unroll") for (int i = 0; i < 4; ++i) brg[i] = b_rg[(LAYER) * 4 + i]; \
        _Pragma("unroll") for (int i = 0; i < 16; ++i) bre[i] = b_re[(LAYER) * 16 + i]; \
        int mycls = 0; float mylo = 0.f, myhi = 0.f; \
        for (int rr = 0; rr < 16; ++rr) { const int r = row0 + rr; f32x4 v[4]; const float rs = load_row(out + (size_t)r * DM, v, lane); store_h(A1 + (size_t)r * DM, v, rs, A, lane); \
            float p[20]; _Pragma("unroll") for (int o = 0; o < 20; ++o) p[o] = 0.f; \
            _Pragma("unroll") for (int j = 0; j < 4; ++j) { const f32x4 h = v[j] * rs * A.a[j] + A.s[j]; \
                _Pragma("unroll") for (int e = 0; e < 4; ++e) { const LAS f32x4* wp = (const LAS f32x4*)(wl + (j * 64 + lane) * 84 + e * 20); \
                    _Pragma("unroll") for (int q4 = 0; q4 < 5; ++q4) { const f32x4 wv = wp[q4]; \
                        p[q4 * 4 + 0] += h[e] * wv[0]; p[q4 * 4 + 1] += h[e] * wv[1]; p[q4 * 4 + 2] += h[e] * wv[2]; p[q4 * 4 + 3] += h[e] * wv[3]; } } \
                asm volatile("" ::: "memory"); } \
            _Pragma("unroll") for (int o = 0; o < 20; ++o) p[o] = wave_sum(p[o]); \
            float lg[4]; _Pragma("unroll") for (int i = 0; i < 4; ++i) lg[i] = p[i] + brg[i]; \
            int gs = 0; float mx = lg[0]; \
            _Pragma("unroll") for (int i = 1; i < 4; ++i) if (lg[i] > mx) { mx = lg[i]; gs = i; } \
            float den = 0.f; _Pragma("unroll") for (int i = 0; i < 4; ++i) den += __expf(lg[i] - mx); \
            const float pg = 1.f / den; \
            float le[4]; _Pragma("unroll") for (int i = 0; i < 4; ++i) { le[i] = gs == 0 ? p[4 + i] + bre[i] : gs == 1 ? p[8 + i] + bre[4 + i] : gs == 2 ? p[12 + i] + bre[8 + i] : p[16 + i] + bre[12 + i]; } \
            int a0 = 0; float va = le[0]; \
            _Pragma("unroll") for (int i = 1; i < 4; ++i) if (le[i] > va) { va = le[i]; a0 = i; } \
            int a1 = -1; float vb = -INFINITY; \
            _Pragma("unroll") for (int i = 0; i < 4; ++i) if (i != a0 && le[i] > vb) { vb = le[i]; a1 = i; } \
            const float e1 = __expf(vb - va), dn = 1.f / (1.f + e1); const float c0 = pg * dn, c1 = pg * e1 * dn;     \
            const int ea = a0 < a1 ? a0 : a1, eb = a0 < a1 ? a1 : a0; const float wlo = a0 < a1 ? c0 : c1, whi = a0 < a1 ? c1 : c0; \
            const int cls = gs * 6 + (ea * (7 - ea)) / 2 + (eb - ea - 1); \
            if (lane == rr) { mycls = cls; mylo = wlo; myhi = whi; } } \
          \
        if (lane < 16) { const int e_ = wave * 16 + lane; const int ls_ = __hip_atomic_fetch_add(rl_cnt + mycls, 1, __ATOMIC_RELAXED, __HIP_MEMORY_SCOPE_WORKGROUP); \
            rl_tok[e_] = row0 + lane; rl_cls[e_] = mycls; rl_slot[e_] = ls_; rl_lo[e_] = mylo; rl_hi[e_] = myhi; } \
        __syncthreads(); \
        if (tid < NCLS) { const int n_ = rl_cnt[tid]; rl_base[tid] = n_ ? atomicAdd(ccnt + ((LAYER) * NCLS + tid) * 64, n_) : 0; } \
        __syncthreads(); \
        if (tid < 128) { const int cl_ = rl_cls[tid], tk_ = rl_tok[tid]; list[cl_ * MT + rl_base[cl_] + rl_slot[tid]] = tk_; cw[tk_ * 2] = rl_lo[tid]; cw[tk_ * 2 + 1] = rl_hi[tid]; } \
        __syncthreads(); \
        if (tid < NCLS) rl_cnt[tid] = 0; \
        __syncthreads(); } \
    } while (0)
#define MOE_TABLE(LAYER) do { \
        LAS int* tab = (LAS int*)(lds + LDSCTL_OFF); \
        if (tid == 0) { int acc_ = 0; for (int j = 0; j < NCLS; ++j) { const int cn = ccnt[((LAYER) * NCLS + j) * 64]; tab[j] = acc_; tab[32 + j] = cn; acc_ += (cn + 255) >> 8; } tab[24] = acc_; } \
        __syncthreads(); } while (0)
#define MOE1_PHASE(LAYER) do { MOE_TABLE(LAYER); \
        MoeSched S{(const LAS int*)(lds + LDSCTL_OFF), list, G, bx, (LAYER), 1}; \
        pg8::Gemm g{(const char*)A1, (const char*)Wgu, DM, DM, DM}; EpiMoe1 E{HID, cw, S}; \
        pg8::gemm_phase<EpiMoe1, MoeSched, true, true>(lds + RING_OFF, g, S, E); } while (0)
#define MOE2_PHASE(LAYER) do { MOE_TABLE(LAYER); \
        MoeSched S{(const LAS int*)(lds + LDSCTL_OFF), list, G, bx, (LAYER), 2}; \
        pg8::Gemm g{(const char*)HID, (const char*)Wd2, 512, 512, 512}; EpiMoe2 E{out, mod + (size_t)(LAYER) * 4 * 6144 + 5120, 6144, S}; \
        pg8::gemm_phase<EpiMoe2, MoeSched, true, false>(lds + RING_OFF, g, S, E); } while (0)
    if (IN(5)) for (int rep_ = 0; rep_ < RPT(5); ++rep_) { if (rep_) xcd_barrier(bar); ROUTER_PHASE(0); }
    SEAM(5);
    if (IN(6)) for (int rep_ = 0; rep_ < RPT(6); ++rep_) { if (rep_) xcd_barrier(bar); MOE1_PHASE(0); }
    SEAM(6);
    if (IN(7)) for (int rep_ = 0; rep_ < RPT(7); ++rep_) { if (rep_) xcd_barrier(bar); MOE2_PHASE(0); }
    SEAM(7);
    if (IN(8)) for (int rep_ = 0; rep_ < RPT(8); ++rep_) { if (rep_) xcd_barrier(bar);
        for (int ch = gw; ch < MT / 16; ch += NGW) {
        const int row0 = ch * 16, b = row0 / SEQ; Affine Akv, Aq;
        load_affine(Akv, g_kv, modkv + (size_t)b * 2048 + 1024, modkv + (size_t)b * 2048, lane);
        load_affine(Aq, g_attn + DM, mod + 4 * 6144 + (size_t)b * 6144 + 1024, mod + 4 * 6144 + (size_t)b * 6144, lane);
        for (int r = row0; r < row0 + 16; ++r) { f32x4 v[4]; const float rs = load_row(out + (size_t)r * DM, v, lane);
            store_h(A1 + (size_t)r * DM, v, rs, Akv, lane); store_h(A2 + (size_t)r * DM, v, rs, Aq, lane); } }
    }
    SEAM(8);
    if (IN(9)) for (int rep_ = 0; rep_ < RPT(9); ++rep_) { if (rep_) xcd_barrier(bar);
        { pg8::Gemm g{(const char*)A1, (const char*)Wkv1, DM, DM, DM}; pg8::StaticOrder S; S.init(MT, DM, G, bx, DM, DM);
          EpiQK E{nullptr, 0, 1.f, A4, kms};
          pg8::gemm_phase<EpiQK, pg8::StaticOrder, true, false>(lds + RING_OFF, g, S, E); }
        { pg8::Gemm g{(const char*)(Wkv1 + (size_t)DM * DM), (const char*)A1, DM, DM, DM}; pg8::StaticOrder S; S.init(DM, MT, G, bx, DM, DM);
          EpiVf E{(unsigned short*)A5, 1};
          pg8::gemm_phase<EpiVf, pg8::StaticOrder, true, false>(lds + RING_OFF, g, S, E); }
        { pg8::Gemm g{(const char*)A2, (const char*)Wq1, DM, DM, DM}; pg8::StaticOrder S; S.init(MT, DM, G, bx, DM, DM);
          EpiF16 E{A3, DM, 0, 0, DM, QSCALE, 0};
          pg8::gemm_phase<EpiF16, pg8::StaticOrder, true, false>(lds + RING_OFF, g, S, E); }
    }
    SEAM(9);
    if (IN(10)) for (int rep_ = 0; rep_ < RPT(10); ++rep_) { if (rep_) xcd_barrier(bar);
        if (G == 256) { const int xg = vcu >> 5, cc = vcu & 31;
#pragma unroll 1
            for (int n = 0; n < 8; ++n) { const int bh = xg * 8 + n, blk = (cc + 4 * n) & 31; moba_unit(bh / NH, bh % NH, blk, A3, A2, A4, (const __bf16*)A5, kms, lds, tid); } }
        else {
#pragma unroll 1
            for (int uu = vcu; uu < NB * NH * NBLK; uu += G) moba_unit((uu >> 5) / NH, (uu >> 5) % NH, uu & 31, A3, A2, A4, (const __bf16*)A5, kms, lds, tid); }
    }
    SEAM(10);
    if (IN(11)) for (int rep_ = 0; rep_ < RPT(11); ++rep_) { if (rep_) xcd_barrier(bar);
        pg8::Gemm g{(const char*)A2, (const char*)Wo1, DM, DM, DM}; pg8::StaticOrder S; S.init(MT, DM, G, bx, DM, DM);
        EpiResid E{out, out, mod + 4 * 6144 + 2048, 6144};
        pg8::gemm_phase<EpiResid, pg8::StaticOrder, true, false>(lds + RING_OFF, g, S, E);
    }
    SEAM(11);
    if (IN(12)) for (int rep_ = 0; rep_ < RPT(12); ++rep_) { if (rep_) xcd_barrier(bar); ROUTER_PHASE(1); }
    SEAM(12);
    if (IN(13)) for (int rep_ = 0; rep_ < RPT(13); ++rep_) { if (rep_) xcd_barrier(bar); MOE1_PHASE(1); }
    SEAM(13);
    if (IN(14)) for (int rep_ = 0; rep_ < RPT(14); ++rep_) { if (rep_) xcd_barrier(bar); MOE2_PHASE(1); }
    SEAM(14);
    if (IN(15)) for (int rep_ = 0; rep_ < RPT(15); ++rep_) { if (rep_) xcd_barrier(bar);
        f32x4 gf[4];
#pragma unroll
        for (int j = 0; j < 4; ++j) gf[j] = *(const f32x4*)(g_final + 4 * lane + 256 * j);
        for (int ch = gw; ch < MT / 16; ch += NGW) { const int row0 = ch * 16;
        for (int r = row0; r < row0 + 16; ++r) { f32x4 v[4]; const float rs = load_row(out + (size_t)r * DM, v, lane);
#pragma unroll
            for (int j = 0; j < 4; ++j) *(f32x4*)(out + (size_t)r * DM + 4 * lane + 256 * j) = v[j] * rs * gf[j]; } }
    }
#undef IN
#undef SEAM
}

extern "C" void kernel_launch(void* const* d_in, const int* in_sizes, int n_in, void* d_out, int out_size, void* d_ws, size_t ws_size, hipStream_t stream) {
    static int grid = 0;
    if (grid == 0) {
        if (n_in != 22 || out_size != MT * DM || ws_size < WS_END) { fprintf(stderr, "kernel_launch: unexpected shapes (n_in %d out %d ws %zu)\n", n_in, out_size, ws_size); grid = -1; return; }
        int dev = 0, cus = 0, per_cu = 0;
        if (hipGetDevice(&dev) != hipSuccess || hipDeviceGetAttribute(&cus, hipDeviceAttributeMultiprocessorCount, dev) != hipSuccess) { grid = -1; return; }
        if (hipFuncSetAttribute((const void*)mk_fwd, hipFuncAttributeMaxDynamicSharedMemorySize, LDS_BYTES) != hipSuccess) { fprintf(stderr, "kernel_launch: hipFuncSetAttribute failed\n"); grid = -1; return; }
        if (hipOccupancyMaxActiveBlocksPerMultiprocessor(&per_cu, (const void*)mk_fwd, NTHREADS, LDS_BYTES) != hipSuccess || per_cu < 1) { fprintf(stderr, "kernel_launch: occupancy query says %d\n", per_cu); }
        (void)hipGetLastError();
        grid = cus;
    }
    if (grid < 0) return;
    (void)hipMemsetAsync((char*)d_ws + WS_CTL, 0, CTL_ZERO_BYTES, stream);
    Args a{};
    for (int i = 0; i < 22; ++i) a.in[i] = (const float*)d_in[i];
    a.out = (float*)d_out; a.ws = (unsigned char*)d_ws;
    f16* A3 = (f16*)((char*)d_ws + WS_A3); f16* A4 = (f16*)((char*)d_ws + WS_A4); f16* A5 = (f16*)((char*)d_ws + WS_A5); float* kms = (float*)((char*)d_ws + WS_KMS);
#ifndef MK_FUSE
#define MK_FUSE 1
#endif
    int region = 0;
    auto run = [&](int lo, int hi) {
        if (MK_FUSE) { a.ph_lo = lo; a.ph_hi = hi; a.bar_region = region++; hipLaunchKernelGGL(mk_fwd, dim3(grid), dim3(NTHREADS), LDS_BYTES, stream, a); }
        else for (int p = lo; p < hi; ++p) { a.ph_lo = p; a.ph_hi = p + 1; a.bar_region = 0; hipLaunchKernelGGL(mk_fwd, dim3(grid), dim3(NTHREADS), LDS_BYTES, stream, a); }
    };
    run(0, N_PHASES);
}
```

```cpp
#include <hip/hip_runtime.h>
#include <cstdio>
#include <cstdint>

#define GAS __attribute__((address_space(1)))
#define LAS __attribute__((address_space(3)))
typedef _Float16 f16;
typedef _Float16 f16x2 __attribute__((ext_vector_type(2)));
typedef _Float16 f16x4 __attribute__((ext_vector_type(4)));
typedef _Float16 f16x8 __attribute__((ext_vector_type(8)));
typedef float f32x2 __attribute__((ext_vector_type(2)));
typedef float f32x4 __attribute__((ext_vector_type(4)));
typedef float f32x16 __attribute__((ext_vector_type(16)));
typedef unsigned u32x2 __attribute__((ext_vector_type(2)));
typedef unsigned u32x4 __attribute__((ext_vector_type(4)));

constexpr int NB = 4, SEQ = 8192, DM = 1024, MT = NB * SEQ, NH = 16, HD = 64;
constexpr int NBLK = 32, MBLK = 256, NE = 16, EFF = 256, NCLS = 24;
constexpr float EPS = 1e-6f;
constexpr float LOG2E = 1.4426950408889634f;
constexpr float QSCALE = 0.125f * LOG2E;
constexpr int NWAVES = 8, NTHREADS = 512;

__device__ __forceinline__ unsigned pkh(float lo, float hi) { f32x2 v = {lo, hi}; f16x2 h = __builtin_convertvector(v, f16x2); return __builtin_bit_cast(unsigned, h); }
typedef __bf16 bf16x2_t __attribute__((ext_vector_type(2)));
__device__ __forceinline__ unsigned pkb(float lo, float hi) { f32x2 v = {lo, hi}; bf16x2_t h = __builtin_convertvector(v, bf16x2_t); return __builtin_bit_cast(unsigned, h); }
__device__ __forceinline__ float wave_sum(float v) {
#pragma unroll
    for (int o = 1; o < 64; o <<= 1) v += __shfl_xor(v, o);
    return v;
}

namespace pg8 {
constexpr int BM = 256, BK = 64, HALF = 128, HTB = HALF * BK * 2, STAGE_BYTES = 8 * HTB, NXCD = 8, WGM = 8;
__host__ __device__ __forceinline__ int lds_byte(int r, int c) { const int st = (r >> 4) * 2 + (c >> 5), rr = r & 15, cc = c & 31, ob = rr * 64 + cc * 2; return st * 1024 + (ob ^ (((ob >> 9) & 1) << 5)); }
__host__ __device__ __forceinline__ void stage_rc(int b, int& R, int& C) { const int st = b / 1024, sb = b % 1024, swz = sb ^ (((sb >> 9) & 1) << 5); R = (st >> 1) * 16 + swz / 64; C = (st & 1) * 32 + (swz % 64) / 2; }
__host__ __device__ __forceinline__ int perm32(int rho) { const int n = rho >> 4, i = rho & 15; return 8 * (i >> 2) + 4 * n + (i & 3); }

struct Unit { int pm, pn, cls, tin; };
struct Gemm { const char* A; const char* Bt; int K, lda, ldb; };

struct StaticOrder {
    int nM, nN, nwg, G, c, lda2, ldb2;
    __device__ __forceinline__ void init(int M, int N, int G_, int c_, int lda, int ldb) { nM = M / BM; nN = N / BM; nwg = nM * nN; G = G_; c = c_; lda2 = lda * 2; ldb2 = ldb * 2; }
    __device__ __forceinline__ bool next(int i, Unit& u) const {
        const long L = (long)i * G + c; if (L >= nwg) return false;
        int wgid = (int)L; { const int q = nwg / NXCD, r = nwg % NXCD, xcd = wgid % NXCD, off = wgid / NXCD; wgid = (xcd < r ? xcd * (q + 1) : r * (q + 1) + (xcd - r) * q) + off; }
        const int nig = WGM * nN, gid = wgid / nig, fm = gid * WGM, gsz = (nM - fm) < WGM ? (nM - fm) : WGM;
        u.pm = fm + ((wgid % nig) % gsz); u.pn = (wgid % nig) / gsz; u.cls = 0; u.tin = 0; return true;
    }
    __device__ __forceinline__ size_t a_off(const Unit& u) const { return (size_t)u.pm * BM * lda2; }
    __device__ __forceinline__ size_t b_off(const Unit& u) const { return (size_t)u.pn * BM * ldb2; }
    __device__ __forceinline__ int row_tok(const Unit&, int) const { return 0; }
};

template <class Epi, class Sched, bool ALIGN_EPI, bool GATHER>
__device__ __forceinline__ void gemm_phase(LAS unsigned char* lds, const Gemm g, const Sched& S, const Epi& E) {
    const int tid = threadIdx.x, wid = __builtin_amdgcn_readfirstlane(tid >> 6), lane = tid & 63, wr = wid >> 2, wc = wid & 3, fr = lane & 15, fq = lane >> 4;
    const int K = g.K, nt = K / BK;
    int Rr[2], Cc[2];
    unsigned cva0[2], cva1[2], nva0[2], nva1[2], voffB[2];
#pragma unroll
    for (int i = 0; i < 2; ++i) { int R, C; stage_rc(tid * 16 + i * 8192, R, C); Rr[i] = R; Cc[i] = C; const int Rb = Epi::PERM ? ((R & ~31) + perm32(R & 31)) : R;
        cva0[i] = (unsigned)(R * g.lda + C) * 2u; cva1[i] = (unsigned)((R + HALF) * g.lda + C) * 2u; nva0[i] = cva0[i]; nva1[i] = cva1[i];
        voffB[i] = (unsigned)(Rb * g.ldb + C) * 2u; }
    const size_t kstep = (size_t)(BK * 2);
    const size_t hstepB = (size_t)HALF * g.ldb * 2;
    const unsigned ldsw = (unsigned)wid * 1024u;
    const int aoff = lds_byte(wr * 64 + fr, fq * 8), boff = lds_byte(wc * 32 + fr, fq * 8);
#define PG8_SA(b, h) (((b) * 2 + (h)) * HTB)
#define PG8_SB(b, h) ((4 + (b) * 2 + (h)) * HTB)
#define PG8_STAGE(bufoff, gbase, voff) do { _Pragma("unroll") for (int _i = 0; _i < 2; ++_i) \
        __builtin_amdgcn_global_load_lds((const unsigned*)((const char*)(gbase) + (voff)[_i]), (LAS unsigned*)(lds + (bufoff) + ldsw + _i * 8192), 16, 0, 0); } while (0)
#define PG8_LDA(dst, b, h) do { _Pragma("unroll") for (int m = 0; m < 4; ++m) _Pragma("unroll") for (int k = 0; k < 2; ++k) dst[m][k] = *(const LAS f16x8*)(lds + PG8_SA(b, h) + aoff + m * 2048 + k * 1024); } while (0)
#define PG8_LDB(dst, b, h) do { _Pragma("unroll") for (int n = 0; n < 2; ++n) _Pragma("unroll") for (int k = 0; k < 2; ++k) dst[n][k] = *(const LAS f16x8*)(lds + PG8_SB(b, h) + boff + n * 2048 + k * 1024); } while (0)
#define PG8_MMA(ai, bj, At, Bt) do { __builtin_amdgcn_s_setprio(1); _Pragma("unroll") for (int m = 0; m < 4; ++m) _Pragma("unroll") for (int n = 0; n < 2; ++n) _Pragma("unroll") for (int k = 0; k < 2; ++k) \
        acc[ai][bj][m][n] = __builtin_amdgcn_mfma_f32_16x16x32_f16(Bt[n][k], At[m][k], acc[ai][bj][m][n], 0, 0, 0); __builtin_amdgcn_s_setprio(0); } while (0)
#define PG8_WAIT_V(n) asm volatile("s_waitcnt vmcnt(" #n ")" ::: "memory")
#define PG8_WAIT_L(n) asm volatile("s_waitcnt lgkmcnt(" #n ")" ::: "memory")
#define PG8_BAR __builtin_amdgcn_s_barrier()
#define PG8_SCHED __builtin_amdgcn_sched_barrier(0)
#define PG8_GATHER_V(dst0, dst1, U) do { _Pragma("unroll") for (int _i = 0; _i < 2; ++_i) { \
        dst0[_i] = (unsigned)(S.row_tok(U, Rr[_i]) * g.lda + Cc[_i]) * 2u; dst1[_i] = (unsigned)(S.row_tok(U, Rr[_i] + HALF) * g.lda + Cc[_i]) * 2u; } } while (0)
    Unit cur, nxt; int ui = 0;
    if (!S.next(0, cur)) return;
    f32x4 acc[2][2][4][2];
#pragma unroll
    for (int a = 0; a < 2; ++a)
#pragma unroll
        for (int b = 0; b < 2; ++b)
#pragma unroll
            for (int m = 0; m < 4; ++m)
#pragma unroll
                for (int n = 0; n < 2; ++n) acc[a][b][m][n] = (f32x4){0.f, 0.f, 0.f, 0.f};
    f16x8 At[4][2], B0[2][2], B1[2][2];
    if constexpr (GATHER) { PG8_GATHER_V(cva0, cva1, cur); }
    const char* cA = g.A + (GATHER ? (size_t)0 : S.a_off(cur)); const char* cB = g.Bt + S.b_off(cur);
    PG8_STAGE(PG8_SB(0, 0), cB, voffB); PG8_STAGE(PG8_SB(0, 1), cB + hstepB, voffB); PG8_STAGE(PG8_SA(0, 0), cA, cva0); PG8_STAGE(PG8_SA(0, 1), cA, cva1);
    if (wr == 1) PG8_BAR;
    PG8_WAIT_V(2); PG8_BAR;
    PG8_STAGE(PG8_SB(1, 0), cB + kstep, voffB); PG8_STAGE(PG8_SA(1, 0), cA + kstep, cva0); PG8_STAGE(PG8_SB(1, 1), cB + hstepB + kstep, voffB);
    PG8_WAIT_V(6); PG8_BAR;
    for (;;) {
        const bool has_next = S.next(ui + 1, nxt);
        const char* nA = has_next ? g.A + (GATHER ? (size_t)0 : S.a_off(nxt)) : cA; const char* nB = has_next ? g.Bt + S.b_off(nxt) : cB;
        if constexpr (GATHER) { if (has_next) { PG8_GATHER_V(nva0, nva1, nxt); } else {
#pragma unroll
            for (int i = 0; i < 2; ++i) { nva0[i] = cva0[i]; nva1[i] = cva1[i]; } } }
        for (int t = 0; t < nt; t += 2) {
            const bool last = (t == nt - 2);
            const char* a1 = cA + (size_t)(t + 1) * kstep;
            const char* a2 = last ? nA : cA + (size_t)(t + 2) * kstep; const char* b2 = last ? nB : cB + (size_t)(t + 2) * kstep;
            const char* a3 = a2 + kstep; const char* b3 = b2 + kstep;
            unsigned w0[2], w1[2];
#pragma unroll
            for (int i = 0; i < 2; ++i) { w0[i] = (GATHER && last) ? nva0[i] : cva0[i]; w1[i] = (GATHER && last) ? nva1[i] : cva1[i]; }
            PG8_LDB(B0, 0, 0); PG8_LDB(B1, 0, 1); PG8_SCHED; PG8_LDA(At, 0, 0); PG8_STAGE(PG8_SA(1, 1), a1, cva1);
            PG8_WAIT_V(8); PG8_WAIT_L(0); PG8_BAR; PG8_MMA(0, 0, At, B0); PG8_MMA(0, 1, At, B1); PG8_BAR; PG8_SCHED;
            PG8_LDA(At, 0, 1); PG8_STAGE(PG8_SB(0, 0), b2, voffB); PG8_STAGE(PG8_SB(0, 1), b2 + hstepB, voffB); PG8_STAGE(PG8_SA(0, 0), a2, w0);
            PG8_WAIT_V(8); PG8_WAIT_L(0); PG8_BAR; PG8_MMA(1, 0, At, B0); PG8_MMA(1, 1, At, B1); PG8_BAR; PG8_SCHED;
            PG8_LDB(B0, 1, 0); PG8_LDB(B1, 1, 1); PG8_SCHED; PG8_LDA(At, 1, 0); PG8_STAGE(PG8_SA(0, 1), a2, w1);
            PG8_WAIT_V(8); PG8_WAIT_L(0); PG8_BAR; PG8_MMA(0, 0, At, B0); PG8_MMA(0, 1, At, B1); PG8_BAR; PG8_SCHED;
            PG8_LDA(At, 1, 1); PG8_STAGE(PG8_SB(1, 0), b3, voffB); PG8_STAGE(PG8_SB(1, 1), b3 + hstepB, voffB); PG8_STAGE(PG8_SA(1, 0), a3, w0);
            PG8_WAIT_V(8); PG8_WAIT_L(0); PG8_BAR; PG8_MMA(1, 0, At, B0); PG8_MMA(1, 1, At, B1); PG8_BAR; PG8_SCHED;
        }
        if constexpr (ALIGN_EPI) { if (wr == 0) PG8_BAR; }
        E(acc, cur, wr, wc, fr, fq);
        if (!has_next) break;
#pragma unroll
        for (int a = 0; a < 2; ++a)
#pragma unroll
            for (int b = 0; b < 2; ++b)
#pragma unroll
                for (int m = 0; m < 4; ++m)
#pragma unroll
                    for (int n = 0; n < 2; ++n) acc[a][b][m][n] = (f32x4){0.f, 0.f, 0.f, 0.f};
        cur = nxt; cA = nA; cB = nB; ++ui;
        if constexpr (GATHER) {
#pragma unroll
            for (int i = 0; i < 2; ++i) { cva0[i] = nva0[i]; cva1[i] = nva1[i]; } }
        if constexpr (ALIGN_EPI) { if (wr == 1) PG8_BAR; }
    }
    PG8_WAIT_V(0);
    if constexpr (!ALIGN_EPI) { if (wr == 0) PG8_BAR; }
    PG8_BAR;
#undef PG8_SA
#undef PG8_SB
#undef PG8_STAGE
#undef PG8_LDA
#undef PG8_LDB
#undef PG8_MMA
#undef PG8_WAIT_V
#undef PG8_WAIT_L
#undef PG8_BAR
#undef PG8_SCHED
#undef PG8_GATHER_V
}
}
constexpr size_t MiB = 1u << 20;
constexpr size_t WS_CTL = 0, CTL_ZERO_BYTES = 1 * MiB;
constexpr size_t WS_MOD = 1 * MiB;
constexpr size_t WS_LIST = 2 * MiB;
constexpr size_t WS_CW = 5 * MiB;
constexpr size_t WS_KMS = 6 * MiB;
constexpr size_t WS_WQKV0 = 8 * MiB, WS_WO0 = 14 * MiB, WS_WKV1 = 16 * MiB, WS_WQ1 = 20 * MiB, WS_WO1 = 22 * MiB;
constexpr size_t WS_WGU = 24 * MiB;
constexpr size_t WS_WD2 = 56 * MiB;
constexpr size_t WS_A1 = 104 * MiB, WS_A2 = 168 * MiB, WS_A3 = 232 * MiB, WS_A4 = 296 * MiB, WS_A5 = 360 * MiB;
constexpr size_t WS_XR = 424 * MiB;
constexpr size_t WS_END = 488 * MiB;
constexpr int CW_BAR = 4096;
constexpr int CW_CNT = 64;

constexpr int RING_OFF = 0, RING_BYTES = 131072;
constexpr int LDSCTL_OFF = RING_BYTES, MISC_OFF = LDSCTL_OFF + 320;
constexpr int LDS_BYTES = 163840;

#define XB_TMO      128
#define XB_XCNT(j)  (256  + 64 * (j))
#define XB_XSUB(j)  (1280 + 64 * (j))
#define XB_XGEN(j)  (2304 + 64 * (j))
#define XB_TOP      3328
#define XB_TOPGEN   3392
#define XCD_BAR_WORDS 3456
#define XB_SPIN_CAP (1u << 18)
__device__ __forceinline__ unsigned xb_ld(unsigned* p)              { return __hip_atomic_load(p, __ATOMIC_RELAXED, __HIP_MEMORY_SCOPE_AGENT); }
__device__ __forceinline__ unsigned xb_add(unsigned* p, unsigned v) { return __hip_atomic_fetch_add(p, v, __ATOMIC_RELAXED, __HIP_MEMORY_SCOPE_AGENT); }
__device__ __forceinline__ unsigned xb_xcc_id() { return (unsigned)__builtin_amdgcn_s_getreg((3 << 11) | 20) & 0xFu; }
#define XB_SPIN(cond, bar) do { unsigned _sp = 0; while (cond) { __builtin_amdgcn_s_sleep(1); \
    if ((++_sp & 255u) == 0u) { if (xb_ld(&(bar)[XB_TMO])) break; if (_sp > XB_SPIN_CAP) { atomicAdd(&(bar)[XB_TMO], 1u); break; } } } } while (0)
struct XcdBarrier { unsigned* bar; unsigned x; volatile LAS unsigned* st; };
__device__ __forceinline__ XcdBarrier xcd_barrier_post(unsigned* bar, volatile LAS unsigned* st) {
    XcdBarrier b; b.bar = bar; b.x = xb_xcc_id(); b.st = st;
    if (threadIdx.x == 0) (void)xb_add(&bar[XB_XCNT(b.x)], 1u);
    return b;
}
__device__ __forceinline__ void xcd_barrier_complete(unsigned* bar, unsigned x, unsigned& nloc, unsigned& nx) {
    const unsigned G = gridDim.x * gridDim.y * gridDim.z;
    unsigned sum, cnt, mine, sp = 0u;
    for (;;) {
        sum = 0u; cnt = 0u; mine = 0u;
#pragma unroll
        for (unsigned j = 0; j < 16; ++j) { const unsigned c = xb_ld(&bar[XB_XCNT(j)]); sum += c; cnt += (c > 0u) ? 1u : 0u; mine = (j == x) ? c : mine; }
        if (sum == G) break;
        __builtin_amdgcn_s_sleep(1);
        if ((++sp & 255u) == 0u) { if (xb_ld(&bar[XB_TMO])) break; if (sp > XB_SPIN_CAP) { atomicAdd(&bar[XB_TMO], 1u); break; } }
    }
    nloc = mine > 0u ? mine : 1u; nx = cnt > 0u ? cnt : 1u;
}
__device__ __forceinline__ void xcd_barrier(const XcdBarrier& b) {
    asm volatile("s_waitcnt vmcnt(0)" ::: "memory");
    __syncthreads();
    if (threadIdx.x == 0) {
        unsigned* bar = b.bar;
        __builtin_amdgcn_s_waitcnt(0);
        unsigned nloc = b.st[0], nx = b.st[1];
        if (nloc == 0u) { xcd_barrier_complete(bar, b.x, nloc, nx); b.st[0] = nloc; b.st[1] = nx; }
        const unsigned old = xb_add(&bar[XB_XSUB(b.x)], 1u);
        const unsigned gen = old / nloc;
        if (old + 1u == (gen + 1u) * nloc) {
            __builtin_amdgcn_fence(__ATOMIC_RELEASE, "agent");
            asm volatile("s_waitcnt vmcnt(0)" ::: "memory");
            const unsigned og = xb_add(&bar[XB_TOP], 1u);
            const unsigned tg = og / nx;
            if (og + 1u == (tg + 1u) * nx) xb_add(&bar[XB_TOPGEN], 1u);
            else XB_SPIN(xb_ld(&bar[XB_TOPGEN]) == tg, bar);
            __builtin_amdgcn_fence(__ATOMIC_ACQUIRE, "agent");
            xb_add(&bar[XB_XGEN(b.x)], 1u);
            asm volatile("s_waitcnt vmcnt(0)" ::: "memory");
        } else {
            XB_SPIN(xb_ld(&bar[XB_XGEN(b.x)]) == gen, bar);
            __builtin_amdgcn_fence(__ATOMIC_ACQUIRE, "agent");
            asm volatile("s_waitcnt vmcnt(0)" ::: "memory");
        }
    }
    __syncthreads();
}

using pg8::Unit; using pg8::BM; using pg8::HALF;
struct EpiF16 {
    static constexpr bool PERM = true;
    f16* O; int ldc; int split_cols; size_t split_stride; int qcols; float qscale; int obf;
    __device__ __forceinline__ void operator()(const f32x4 (&acc)[2][2][4][2], const Unit& u, int wr, int wc, int fr, int fq) const {
        const int row0 = u.pm * BM + wr * 64 + fr; int colt = u.pn * BM; f16* base = O;
        const float sc = (colt < qcols) ? qscale : 1.f;
        if (split_cols) { const int t = colt / split_cols; base += (size_t)t * split_stride; colt -= t * split_cols; }
        const int col0 = colt + wc * 32 + 8 * fq;
#pragma unroll
        for (int ai = 0; ai < 2; ++ai)
#pragma unroll
            for (int m = 0; m < 4; ++m) { f16* rowp = base + (size_t)(row0 + ai * HALF + m * 16) * ldc + col0;
#pragma unroll
                for (int bj = 0; bj < 2; ++bj) { const f32x4 v0 = acc[ai][bj][m][0] * sc, v1 = acc[ai][bj][m][1] * sc;
                    u32x4 w; if (obf) { w.x = pkb(v0[0], v0[1]); w.y = pkb(v0[2], v0[3]); w.z = pkb(v1[0], v1[1]); w.w = pkb(v1[2], v1[3]); }
                    else { w.x = pkh(v0[0], v0[1]); w.y = pkh(v0[2], v0[3]); w.z = pkh(v1[0], v1[1]); w.w = pkh(v1[2], v1[3]); }
                    *(u32x4*)(rowp + bj * HALF) = w; } }
    }
};
struct EpiKV1 {
    static constexpr bool PERM = true;
    f16* O; int ldc; int split_cols; size_t split_stride; float* kms;
    __device__ __forceinline__ void operator()(const f32x4 (&acc)[2][2][4][2], const Unit& u, int wr, int wc, int fr, int fq) const {
        const int row0 = u.pm * BM + wr * 64 + fr; int colt = u.pn * BM; f16* base = O;
        const bool isk = colt < DM; const int kcol0 = colt + wc * 32 + 8 * fq;
        if (split_cols) { const int t = colt / split_cols; base += (size_t)t * split_stride; colt -= t * split_cols; }
        const int col0 = colt + wc * 32 + 8 * fq;
        f32x4 cs[2][2];
#pragma unroll
        for (int bj = 0; bj < 2; ++bj) { cs[bj][0] = (f32x4){0.f, 0.f, 0.f, 0.f}; cs[bj][1] = (f32x4){0.f, 0.f, 0.f, 0.f}; }
#pragma unroll
        for (int ai = 0; ai < 2; ++ai)
#pragma unroll
            for (int m = 0; m < 4; ++m) { f16* rowp = base + (size_t)(row0 + ai * HALF + m * 16) * ldc + col0;
#pragma unroll
                for (int bj = 0; bj < 2; ++bj) { const f32x4 v0 = acc[ai][bj][m][0], v1 = acc[ai][bj][m][1];
                    cs[bj][0] += v0; cs[bj][1] += v1;
                    u32x4 w; w.x = pkh(v0[0], v0[1]); w.y = pkh(v0[2], v0[3]); w.z = pkh(v1[0], v1[1]); w.w = pkh(v1[2], v1[3]);
                    *(u32x4*)(rowp + bj * HALF) = w; } }
        if (isk) {
#pragma unroll
            for (int bj = 0; bj < 2; ++bj)
#pragma unroll
                for (int n = 0; n < 2; ++n)
#pragma unroll
                    for (int e = 0; e < 4; ++e) { float s = cs[bj][n][e];
                        s += __shfl_xor(s, 1); s += __shfl_xor(s, 2); s += __shfl_xor(s, 4); s += __shfl_xor(s, 8);
                        if (fr == 0) atomicAdd(kms + (size_t)u.pm * DM + kcol0 + bj * HALF + 4 * n + e, s); }
        }
    }
};
struct EpiResid {
    static constexpr bool PERM = true;
    const float* basef; const f16* baseh; f16* xr; const float* gate; int ldg;
    __device__ __forceinline__ void operator()(const f32x4 (&acc)[2][2][4][2], const Unit& u, int wr, int wc, int fr, int fq) const {
        const int b = (u.pm * BM) / SEQ; const int col0 = u.pn * BM + wc * 32 + 8 * fq;
        f32x4 gv[2][2];
#pragma unroll
        for (int bj = 0; bj < 2; ++bj)
#pragma unroll
            for (int n = 0; n < 2; ++n) { gv[bj][n] = *(const f32x4*)(gate + (size_t)b * ldg + col0 + bj * HALF + n * 4) + 1.0f; }
#pragma unroll
        for (int ai = 0; ai < 2; ++ai)
#pragma unroll
            for (int m = 0; m < 4; ++m) { const size_t off = (size_t)(u.pm * BM + ai * HALF + wr * 64 + m * 16 + fr) * DM + col0;
#pragma unroll
                for (int bj = 0; bj < 2; ++bj) { f32x4 b0, b1;
                    if (basef) { b0 = *(const f32x4*)(basef + off + bj * HALF); b1 = *(const f32x4*)(basef + off + bj * HALF + 4); }
                    else { const f16x8 hb = *(const f16x8*)(baseh + off + bj * HALF); b0 = (f32x4){(float)hb[0], (float)hb[1], (float)hb[2], (float)hb[3]}; b1 = (f32x4){(float)hb[4], (float)hb[5], (float)hb[6], (float)hb[7]}; }
                    const f32x4 v0 = b0 + gv[bj][0] * acc[ai][bj][m][0], v1 = b1 + gv[bj][1] * acc[ai][bj][m][1];
                    u32x4 w; w.x = pkh(v0[0], v0[1]); w.y = pkh(v0[2], v0[3]); w.z = pkh(v1[0], v1[1]); w.w = pkh(v1[2], v1[3]);
                    *(u32x4*)(xr + off + bj * HALF) = w; } }
    }
};

struct EpiQK {
    static constexpr bool PERM = true;
    f16* Qout; int qcols; float qscale; f16* Kf; float* kms;
    __device__ __forceinline__ void operator()(const f32x4 (&acc)[2][2][4][2], const Unit& u, int wr, int wc, int fr, int fq) const {
        const int row0 = u.pm * BM + wr * 64 + fr; const int colt = u.pn * BM;
        if (colt < qcols) {
            const int col0 = colt + wc * 32 + 8 * fq;
#pragma unroll
            for (int ai = 0; ai < 2; ++ai)
#pragma unroll
                for (int m = 0; m < 4; ++m) { f16* rowp = Qout + (size_t)(row0 + ai * HALF + m * 16) * DM + col0;
#pragma unroll
                    for (int bj = 0; bj < 2; ++bj) { const f32x4 v0 = acc[ai][bj][m][0] * qscale, v1 = acc[ai][bj][m][1] * qscale;
                        u32x4 w; w.x = pkh(v0[0], v0[1]); w.y = pkh(v0[2], v0[3]); w.z = pkh(v1[0], v1[1]); w.w = pkh(v1[2], v1[3]);
                        *(u32x4*)(rowp + bj * HALF) = w; } }
            return;
        }
        const int kc0 = colt - qcols + wc * 32 + 8 * fq;
        f32x4 cs[2][2];
#pragma unroll
        for (int bj = 0; bj < 2; ++bj) { cs[bj][0] = (f32x4){0.f, 0.f, 0.f, 0.f}; cs[bj][1] = (f32x4){0.f, 0.f, 0.f, 0.f}; }
#pragma unroll
        for (int ai = 0; ai < 2; ++ai)
#pragma unroll
            for (int m = 0; m < 4; ++m) { const int row = row0 + ai * HALF + m * 16; const int bb = row / SEQ, k = row % SEQ, T = k >> 5, r = k & 31;
#pragma unroll
                for (int bj = 0; bj < 2; ++bj) { const f32x4 v0 = acc[ai][bj][m][0], v1 = acc[ai][bj][m][1];
                    cs[bj][0] += v0; cs[bj][1] += v1;
                    const int kc = kc0 + bj * HALF, head = kc >> 6, d = kc & 63, s = d >> 4, hh = (d >> 3) & 1;
                    u32x4 w; w.x = pkh(v0[0], v0[1]); w.y = pkh(v0[2], v0[3]); w.z = pkh(v1[0], v1[1]); w.w = pkh(v1[2], v1[3]);
                    *(u32x4*)(Kf + ((((size_t)(bb * NH + head) * 256 + T) * 4 + s) * 64 + hh * 32 + r) * 8) = w; } }
        if (kms) {
#pragma unroll
            for (int bj = 0; bj < 2; ++bj)
#pragma unroll
                for (int n = 0; n < 2; ++n)
#pragma unroll
                    for (int e = 0; e < 4; ++e) { float s = cs[bj][n][e];
                        s += __shfl_xor(s, 1); s += __shfl_xor(s, 2); s += __shfl_xor(s, 4); s += __shfl_xor(s, 8);
                        if (fr == 0) atomicAdd(kms + (size_t)u.pm * DM + kc0 + bj * HALF + 4 * n + e, s); }
        }
    }
};
struct EpiVf {
    static constexpr bool PERM = true;
    unsigned short* Vf; int obf;
    __device__ __forceinline__ void operator()(const f32x4 (&acc)[2][2][4][2], const Unit& u, int wr, int wc, int fr, int fq) const {
#pragma unroll
        for (int ai = 0; ai < 2; ++ai)
#pragma unroll
            for (int m = 0; m < 4; ++m) { const int hd = u.pm * BM + ai * HALF + wr * 64 + m * 16 + fr; const int head = hd >> 6, d = hd & 63, d0 = d >> 5, r = d & 31;
#pragma unroll
                for (int bj = 0; bj < 2; ++bj) { const int t0 = u.pn * BM + bj * HALF + wc * 32 + 8 * fq; const int bb = t0 / SEQ, k = t0 % SEQ, T = k >> 5, kk = k & 31, sp = kk >> 4, j0 = ((kk & 15) >> 3) * 4;
                    const f32x4 v0 = acc[ai][bj][m][0], v1 = acc[ai][bj][m][1];
                    u32x2 w0, w1; if (obf) { w0.x = pkb(v0[0], v0[1]); w0.y = pkb(v0[2], v0[3]); w1.x = pkb(v1[0], v1[1]); w1.y = pkb(v1[2], v1[3]); }
                    else { w0.x = pkh(v0[0], v0[1]); w0.y = pkh(v0[2], v0[3]); w1.x = pkh(v1[0], v1[1]); w1.y = pkh(v1[2], v1[3]); }
                    unsigned short* p = Vf + (((((size_t)(bb * NH + head) * 256 + T) * 2 + d0) * 2 + sp) * 64 + r) * 8 + j0;
                    *(u32x2*)p = w0; *(u32x2*)(p + 32 * 8) = w1; } }
    }
};

struct MoeSched {
    const LAS int* tab; const int* list; int G, c, layer, stage;
    __device__ __forceinline__ bool next(int i, Unit& u) const {
        const int ntile = __builtin_amdgcn_readfirstlane(tab[24]); const long L = (long)i * G + c; if (L >= (long)ntile * 4) return false;
        const int tile = (int)(L >> 2), sub = (int)(L & 3);
        int cls = 0;
#pragma unroll 1
        for (int j = 1; j < NCLS; ++j) cls += (tab[j] <= tile) ? 1 : 0;
        cls = __builtin_amdgcn_readfirstlane(cls);
        u.pm = tile; u.pn = sub; u.cls = cls; u.tin = tile - __builtin_amdgcn_readfirstlane(tab[cls]); return true;
    }
    __device__ __forceinline__ size_t a_off(const Unit& u) const { return (size_t)u.pm * BM * 512 * 2; }
    __device__ __forceinline__ size_t b_off(const Unit& u) const {
        if (stage == 1) { const int g = u.cls / 6, p = u.cls % 6; const int a = p < 3 ? 0 : (p < 5 ? 1 : 2), bb = p < 3 ? p + 1 : (p < 5 ? p - 1 : 3);
            const int e = g * 4 + ((u.pn >> 1) ? bb : a); return ((size_t)(layer * NE + e) * 512 + (size_t)(u.pn & 1) * 256) * DM * 2; }
        return ((size_t)(layer * NCLS + u.cls) * DM + (size_t)u.pn * 256) * 512 * 2;
    }
    __device__ __forceinline__ int row_tok(const Unit& u, int r) const { int idx = u.tin * BM + r; const int cmax = tab[32 + u.cls] - 1; idx = idx < cmax ? idx : cmax; return list[u.cls * MT + idx]; }
};
struct EpiMoe1 {
    static constexpr bool PERM = true;
    f16* hid; const float* cw; MoeSched S;
    __device__ __forceinline__ void operator()(const f32x4 (&acc)[2][2][4][2], const Unit& u, int wr, int wc, int fr, int fq) const {
        const int k = u.pn >> 1, pnc = u.pn & 1; const int col0 = k * 256 + pnc * 128 + wc * 32 + 8 * fq;
#pragma unroll
        for (int ai = 0; ai < 2; ++ai)
#pragma unroll
            for (int m = 0; m < 4; ++m) { const int r = ai * HALF + wr * 64 + m * 16 + fr; const int tok = S.row_tok(u, r); const float cwv = cw[tok * 2 + k];
                float o[8];
#pragma unroll
                for (int n = 0; n < 2; ++n)
#pragma unroll
                    for (int e = 0; e < 4; ++e) { const float gg = acc[ai][0][m][n][e], uu = acc[ai][1][m][n][e];
                        const float sg = gg * __builtin_amdgcn_rcpf(1.f + __builtin_amdgcn_exp2f(-gg * LOG2E)); o[n * 4 + e] = sg * uu * cwv; }
                u32x4 w; w.x = pkh(o[0], o[1]); w.y = pkh(o[2], o[3]); w.z = pkh(o[4], o[5]); w.w = pkh(o[6], o[7]);
                *(u32x4*)(hid + (size_t)(u.pm * BM + r) * 512 + col0) = w; }
    }
};
struct EpiMoe2 {
    static constexpr bool PERM = true;
    f16* xr; const float* gate; int ldg; MoeSched S;
    __device__ __forceinline__ void operator()(const f32x4 (&acc)[2][2][4][2], const Unit& u, int wr, int wc, int fr, int fq) const {
        const int col0 = u.pn * BM + wc * 32 + 8 * fq; const int cnt = S.tab[32 + u.cls];
#pragma unroll
        for (int ai = 0; ai < 2; ++ai)
#pragma unroll
            for (int m = 0; m < 4; ++m) { const int r = ai * HALF + wr * 64 + m * 16 + fr; const int idx = u.tin * BM + r;
                if (idx < cnt) { const int tok = S.list[u.cls * MT + idx]; const int b = tok / SEQ; f16* xp = xr + (size_t)tok * DM + col0; const float* gr = gate + (size_t)b * ldg + col0;
#pragma unroll
                    for (int bj = 0; bj < 2; ++bj) { const f32x4 g0 = *(const f32x4*)(gr + bj * HALF) + 1.0f, g1 = *(const f32x4*)(gr + bj * HALF + 4) + 1.0f; const f16x8 hb = *(const f16x8*)(xp + bj * HALF);
                        const f32x4 b0 = {(float)hb[0], (float)hb[1], (float)hb[2], (float)hb[3]}, b1 = {(float)hb[4], (float)hb[5], (float)hb[6], (float)hb[7]};
                        const f32x4 v0 = b0 + g0 * acc[ai][bj][m][0], v1 = b1 + g1 * acc[ai][bj][m][1];
                        u32x4 w; w.x = pkh(v0[0], v0[1]); w.y = pkh(v0[2], v0[3]); w.z = pkh(v1[0], v1[1]); w.w = pkh(v1[2], v1[3]);
                        *(u32x4*)(xp + bj * HALF) = w; } } }
    }
};
__device__ __forceinline__ void mod_item(const float* __restrict__ c, const float* __restrict__ W, const float* __restrict__ bias, float* out, int N, int n0, LAS float* red, int tid) {
    const int wave = tid >> 6, lane = tid & 63;
    float a0 = 0.f, a1 = 0.f, a2 = 0.f, a3 = 0.f;
    const float* wp = W + (size_t)(wave * 128) * N + n0 + lane;
    const float* cp = c + wave * 128;
#pragma unroll 16
    for (int k = 0; k < 128; ++k) { const float w = wp[(size_t)k * N]; a0 += cp[k] * w; a1 += cp[DM + k] * w; a2 += cp[2 * DM + k] * w; a3 += cp[3 * DM + k] * w; }
    red[(wave * 4 + 0) * 64 + lane] = a0; red[(wave * 4 + 1) * 64 + lane] = a1; red[(wave * 4 + 2) * 64 + lane] = a2; red[(wave * 4 + 3) * 64 + lane] = a3;
    __syncthreads();
    if (tid < 256) { const int b = tid >> 6, l = tid & 63; float s = bias[n0 + l];
#pragma unroll
        for (int w = 0; w < 8; ++w) s += red[(w * 4 + b) * 64 + l];
        out[(size_t)b * N + n0 + l] = s; }
    __syncthreads();
}
__device__ __forceinline__ void tr_item(const float* __restrict__ src, int ld_src, int k0, int n0, f16* dst, int ld_dst, int drow, int dk, LAS float* scr, int lane) {
#pragma unroll 8
    for (int i = 0; i < 32; ++i) { const int kk = 2 * i + (lane >> 5); scr[kk * 33 + (lane & 31)] = src[(size_t)(k0 + kk) * ld_src + n0 + (lane & 31)]; }
    asm volatile("s_waitcnt lgkmcnt(0)" ::: "memory");
    const int c = lane & 7;
#pragma unroll
    for (int j = 0; j < 4; ++j) { const int n = (lane >> 3) + 8 * j; const LAS float* s = scr + (8 * c) * 33 + n;
        u32x4 o; o.x = pkh(s[0 * 33], s[1 * 33]); o.y = pkh(s[2 * 33], s[3 * 33]); o.z = pkh(s[4 * 33], s[5 * 33]); o.w = pkh(s[6 * 33], s[7 * 33]);
        *(u32x4*)(dst + (size_t)(drow + n) * ld_dst + dk + k0 + 8 * c) = o; }
    asm volatile("s_waitcnt lgkmcnt(0)" ::: "memory");
}
struct Affine { f32x4 a[4], s[4]; };
__device__ __forceinline__ void load_affine(Affine& A, const float* __restrict__ g, const float* sc, const float* sh, int lane) {
#pragma unroll
    for (int j = 0; j < 4; ++j) { const int i = 4 * lane + 256 * j; const f32x4 gv = *(const f32x4*)(g + i), sv = *(const f32x4*)(sc + i); A.a[j] = gv * (sv + 1.0f); A.s[j] = *(const f32x4*)(sh + i); }
}
__device__ __forceinline__ void store_h(f16* orow, const f32x4 (&v)[4], float rs, const Affine& A, int lane) {
#pragma unroll
    for (int j = 0; j < 4; ++j) { const f32x4 h = v[j] * rs * A.a[j] + A.s[j]; u32x2 w; w.x = pkh(h[0], h[1]); w.y = pkh(h[2], h[3]); *(u32x2*)(orow + 4 * lane + 256 * j) = w; }
}
__device__ __forceinline__ float load_row_h(const f16* xrow, f32x4 (&v)[4], int lane) {
    float s = 0.f;
#pragma unroll
    for (int j = 0; j < 4; ++j) { const f16x4 hv = *(const f16x4*)(xrow + 4 * lane + 256 * j); v[j] = (f32x4){(float)hv[0], (float)hv[1], (float)hv[2], (float)hv[3]}; s += (v[j][0] * v[j][0] + v[j][1] * v[j][1]) + (v[j][2] * v[j][2] + v[j][3] * v[j][3]); }
    return __builtin_amdgcn_rsqf(wave_sum(s) * (1.f / DM) + EPS);
}
__device__ __forceinline__ float load_row(const float* xrow, f32x4 (&v)[4], int lane) {
    float s = 0.f;
#pragma unroll
    for (int j = 0; j < 4; ++j) { v[j] = *(const f32x4*)(xrow + 4 * lane + 256 * j); s += (v[j][0] * v[j][0] + v[j][1] * v[j][1]) + (v[j][2] * v[j][2] + v[j][3] * v[j][3]); }
    return __builtin_amdgcn_rsqf(wave_sum(s) * (1.f / DM) + EPS);
}

__device__ __forceinline__ void sb_naive_item(int idx, f16* Q, const f16* __restrict__ K, const f16* __restrict__ V) {
    const int t = idx % SEQ, h = (idx / SEQ) % NH, b = idx / (SEQ * NH);
    f16* qp = Q + (size_t)(b * SEQ + t) * DM + h * HD;
    f16 q[HD]; float o[HD];
#pragma unroll
    for (int d = 0; d < HD; ++d) { q[d] = qp[d]; o[d] = 0.f; }
    float R = 0.f;
    for (int s = t - 1; s >= 0; --s) {
        const f16* kp = K + (size_t)(b * SEQ + s) * DM + h * HD;
        float z = 0.f;
#pragma unroll
        for (int d = 0; d < HD; ++d) z += (float)q[d] * (float)kp[d];
        z = fminf(z, 126.f);
        const float L = log2f(1.f + exp2f(z));
        const float Cc = R + L;
        const float w = exp2f(z - Cc);
        const f16* vp = V + (size_t)(b * SEQ + s) * DM + h * HD;
#pragma unroll
        for (int d = 0; d < HD; ++d) o[d] += w * (float)vp[d];
        R = Cc;
        if (R > 152.f) break;
    }
#pragma unroll
    for (int d = 0; d < HD; ++d) qp[d] = (f16)o[d];
}
__device__ __forceinline__ void moba_naive_item(int idx, f16* Q, const f16* __restrict__ K, const f16* __restrict__ V, const float* __restrict__ kms) {
    const int t = idx % SEQ, h = (idx / SEQ) % NH, b = idx / (SEQ * NH);
    f16* qp = Q + (size_t)(b * SEQ + t) * DM + h * HD;
    f16 q[HD]; float o[HD];
#pragma unroll
    for (int d = 0; d < HD; ++d) { q[d] = qp[d]; o[d] = 0.f; }
    const int own = t / MBLK;
    float v0 = -INFINITY, v1 = -INFINITY, v2 = -INFINITY; int i0 = -1, i1 = -1, i2 = -1;
    for (int j = 0; j < own; ++j) {
        const float* kp = kms + (size_t)(b * NBLK + j) * DM + h * HD;
        float gsc = 0.f;
#pragma unroll
        for (int d = 0; d < HD; ++d) gsc += (float)q[d] * kp[d];
        if (gsc > v0) { v2 = v1; i2 = i1; v1 = v0; i1 = i0; v0 = gsc; i0 = j; }
        else if (gsc > v1) { v2 = v1; i2 = i1; v1 = gsc; i1 = j; }
        else if (gsc > v2) { v2 = gsc; i2 = j; }
    }
    const float slope2 = exp2f(-0.5f * (float)(h + 1)) * LOG2E;
    float m = -INFINITY, l = 0.f;
#pragma unroll
    for (int si = 0; si < 4; ++si) {
        const int j = si == 0 ? i0 : si == 1 ? i1 : si == 2 ? i2 : own;
        if (j < 0) continue;
        const int k_lo = j * MBLK, k_hi = (j == own) ? t : (k_lo + MBLK - 1);
        for (int s = k_lo; s <= k_hi; ++s) {
            const f16* kp = K + (size_t)(b * SEQ + s) * DM + h * HD;
            float z = 0.f;
#pragma unroll
            for (int d = 0; d < HD; ++d) z += (float)q[d] * (float)kp[d];
            z = z - slope2 * (float)(t - s);
            const float mn = fmaxf(m, z);
            const float al = exp2f(m - mn), p = exp2f(z - mn);
            l = l * al + p;
            const f16* vp = V + (size_t)(b * SEQ + s) * DM + h * HD;
#pragma unroll
            for (int d = 0; d < HD; ++d) o[d] = o[d] * al + p * (float)vp[d];
            m = mn;
        }
    }
    const float inv = 1.f / l;
#pragma unroll
    for (int d = 0; d < HD; ++d) qp[d] = (f16)(o[d] * inv);
}


__device__ __forceinline__ int crow16(int i, int h) { return (i & 3) + 8 * (i >> 2) + 4 * h; }
__device__ __forceinline__ f16x8 pack8(const f32x16& v, int s) {
    u32x4 p; p.x = pkh(v[8 * s + 0], v[8 * s + 1]); p.y = pkh(v[8 * s + 2], v[8 * s + 3]); p.z = pkh(v[8 * s + 4], v[8 * s + 5]); p.w = pkh(v[8 * s + 6], v[8 * s + 7]);
    return __builtin_bit_cast(f16x8, p);
}
__device__ __forceinline__ void sb_item(int item, const f16* __restrict__ Q, const f16* __restrict__ Kf, const f16* __restrict__ Vf, f16* O, int lane) {
    const int r = lane & 31, h = lane >> 5;
    const int qg = item & 255, head = (item >> 8) & 15, b = item >> 12;
    const int q0 = qg * 32;
    const f16* qrow = Q + (size_t)(b * SEQ + q0 + r) * DM + head * HD; f16* orow = O + (size_t)(b * SEQ + q0 + r) * DM + head * HD;
    f16x8 qf[4];
#pragma unroll
    for (int s = 0; s < 4; ++s) qf[s] = *(const f16x8*)(qrow + 16 * s + 8 * h);
    f16x8 tri[2], ones;
#pragma unroll
    for (int s = 0; s < 2; ++s)
#pragma unroll
        for (int j = 0; j < 8; ++j) { const int k = 16 * s + 8 * (j >> 2) + 4 * h + (j & 3); tri[s][j] = (k >= r) ? (f16)1.0f : (f16)0.0f; }
#pragma unroll
    for (int j = 0; j < 8; ++j) ones[j] = (f16)1.0f;
    f32x16 o0, o1;
#pragma unroll
    for (int i = 0; i < 16; ++i) { o0[i] = 0.f; o1[i] = 0.f; }
    float R = 0.f;
    const f16x8* kfb = (const f16x8*)Kf + (size_t)(b * NH + head) * 256 * 256 + lane;
    const f16x8* vfb = (const f16x8*)Vf + (size_t)(b * NH + head) * 256 * 256 + lane;
#define SB_LOAD(KF, VF, TT) do { const size_t t_ = (size_t)((TT) > 0 ? (TT) : 0) * 256; _Pragma("unroll") for (int s = 0; s < 4; ++s) { KF[s] = kfb[t_ + s * 64]; VF[s] = vfb[t_ + s * 64]; } } while (0)
#define SB_TILE(KF, VF, TT) do { \
        f32x16 x; _Pragma("unroll") for (int i = 0; i < 16; ++i) x[i] = 0.f; \
        _Pragma("unroll") for (int s = 0; s < 4; ++s) x = __builtin_amdgcn_mfma_f32_32x32x16_f16(KF[s], qf[s], x, 0, 0, 0); \
        const bool diag = ((TT) == qg); \
        f32x16 L; \
        _Pragma("unroll") for (int i = 0; i < 16; ++i) { const float z = __builtin_fminf(x[i], 126.f); x[i] = z; L[i] = __builtin_amdgcn_logf(1.f + __builtin_amdgcn_exp2f(z)); } \
        if (diag) { _Pragma("unroll") for (int i = 0; i < 16; ++i) if (crow16(i, h) >= r) L[i] = 0.f; } \
        const f16x8 lb0 = pack8(L, 0), lb1 = pack8(L, 1); \
        f32x16 y, tt; _Pragma("unroll") for (int i = 0; i < 16; ++i) { y[i] = R; tt[i] = 0.f; } \
        y = __builtin_amdgcn_mfma_f32_32x32x16_f16(tri[0], lb0, y, 0, 0, 0); y = __builtin_amdgcn_mfma_f32_32x32x16_f16(tri[1], lb1, y, 0, 0, 0); \
        tt = __builtin_amdgcn_mfma_f32_32x32x16_f16(ones, lb0, tt, 0, 0, 0); tt = __builtin_amdgcn_mfma_f32_32x32x16_f16(ones, lb1, tt, 0, 0, 0); \
        f32x16 w; _Pragma("unroll") for (int i = 0; i < 16; ++i) w[i] = __builtin_amdgcn_exp2f(x[i] - y[i]); \
        if (diag) { _Pragma("unroll") for (int i = 0; i < 16; ++i) if (crow16(i, h) >= r) w[i] = 0.f; } \
        R += tt[0]; \
        const f16x8 pb0 = pack8(w, 0), pb1 = pack8(w, 1); \
        o0 = __builtin_amdgcn_mfma_f32_32x32x16_f16(VF[0], pb0, o0, 0, 0, 0); o0 = __builtin_amdgcn_mfma_f32_32x32x16_f16(VF[1], pb1, o0, 0, 0, 0); \
        o1 = __builtin_amdgcn_mfma_f32_32x32x16_f16(VF[2], pb0, o1, 0, 0, 0); o1 = __builtin_amdgcn_mfma_f32_32x32x16_f16(VF[3], pb1, o1, 0, 0, 0); } while (0)
    f16x8 kA[4], vA[4], kB[4], vB[4];
    SB_LOAD(kA, vA, qg);
#pragma unroll 1
    for (int T = qg; T >= 0; T -= 2) {
        SB_LOAD(kB, vB, T - 1);
        __builtin_amdgcn_sched_barrier(0);
        SB_TILE(kA, vA, T);
        if (T == 0 || __all(R >= 152.f)) break;
        SB_LOAD(kA, vA, T - 2);
        __builtin_amdgcn_sched_barrier(0);
        SB_TILE(kB, vB, T - 1);
        if (__all(R >= 152.f)) break;
    }
#undef SB_LOAD
#undef SB_TILE
#pragma unroll
    for (int g = 0; g < 4; ++g) {
        u32x2 w0, w1; w0.x = pkh(o0[4 * g], o0[4 * g + 1]); w0.y = pkh(o0[4 * g + 2], o0[4 * g + 3]); w1.x = pkh(o1[4 * g], o1[4 * g + 1]); w1.y = pkh(o1[4 * g + 2], o1[4 * g + 3]);
        *(u32x2*)(orow + 8 * g + 4 * h) = w0; *(u32x2*)(orow + 32 + 8 * g + 4 * h) = w1;
    }
}

typedef __bf16 bf16x2 __attribute__((ext_vector_type(2)));
typedef __bf16 bf16x4 __attribute__((ext_vector_type(4)));
typedef __bf16 bf16x8 __attribute__((ext_vector_type(8)));
__device__ __forceinline__ bf16x8 pack8b(const f32x16& v, int s) {
    u32x4 p; p.x = pkb(v[8 * s + 0], v[8 * s + 1]); p.y = pkb(v[8 * s + 2], v[8 * s + 3]); p.z = pkb(v[8 * s + 4], v[8 * s + 5]); p.w = pkb(v[8 * s + 6], v[8 * s + 7]);
    return __builtin_bit_cast(bf16x8, p);
}
constexpr int MB_SL = 0;
constexpr int MB_SLP = 136;
constexpr int MB_SLL = 768 * MB_SLP;
constexpr int MB_M = MB_SLL + 3072;
constexpr int MB_CNT = MB_M + 1024;
constexpr int MB_LST = MB_CNT + 128;
constexpr int MB_END = MB_LST + 16384;
static_assert(MB_END <= RING_BYTES, "MoBA LDS map");
#define TOP3_INSERT(v, ix) do { const float v_ = (v); const int i_ = (ix); \
        if (v_ > t0) { t2 = t1; j2 = j1; t1 = t0; j1 = j0; t0 = v_; j0 = i_; } else if (v_ > t1) { t2 = t1; j2 = j1; t1 = v_; j1 = i_; } else if (v_ > t2) { t2 = v_; j2 = i_; } } while (0)
__device__ __forceinline__ void moba_unit(int b, int head, int blk, const f16* __restrict__ Q, f16* O, const f16* __restrict__ Kf, const __bf16* __restrict__ Vf, const float* __restrict__ kms, LAS unsigned char* lds, int tid) {
    const int lane = tid & 63, wave = __builtin_amdgcn_readfirstlane(tid >> 6), r = lane & 31, h = lane >> 5;
    LAS unsigned char* slots = lds + MB_SL; LAS float* sll = (LAS float*)(lds + MB_SLL); LAS float* mref = (LAS float*)(lds + MB_M);
    LAS int* cnt = (LAS int*)(lds + MB_CNT); LAS unsigned short* qlist = (LAS unsigned short*)(lds + MB_LST);
    const float slope2 = __builtin_amdgcn_exp2f(-0.5f * (float)(head + 1)) * LOG2E;
    const size_t tok0 = (size_t)b * SEQ + (size_t)blk * MBLK;
    const f16x8* kfb = (const f16x8*)Kf + (size_t)(b * NH + head) * 256 * 256 + lane;
    const bf16x8* vfb = (const bf16x8*)Vf + (size_t)(b * NH + head) * 256 * 256 + lane;
    if (tid < 32) cnt[tid] = 0;
    __syncthreads();
    const int qlw = wave * 32 + r;
#define MB_LOAD(KF, VF, TT) do { const size_t t_ = (size_t)(TT) * 256; _Pragma("unroll") for (int s = 0; s < 4; ++s) { KF[s] = kfb[t_ + s * 64]; VF[s] = vfb[t_ + s * 64]; } } while (0)
    {
        const f16* qrow = Q + (tok0 + qlw) * DM + head * HD;
        f16x8 qf[4];
#pragma unroll
        for (int s = 0; s < 4; ++s) qf[s] = *(const f16x8*)(qrow + 16 * s + 8 * h);
        f16x8 kd[4];
#pragma unroll
        for (int s = 0; s < 4; ++s) kd[s] = kfb[((size_t)blk * 8 + wave) * 256 + s * 64];
        f32x16 g;
#pragma unroll
        for (int i = 0; i < 16; ++i) g[i] = 0.f;
#pragma unroll
        for (int s = 0; s < 4; ++s) { const float* kp = kms + (size_t)(b * NBLK + r) * DM + head * HD + 16 * s + 8 * h;
            const f32x4 a0 = *(const f32x4*)kp * (1.f / MBLK), a1 = *(const f32x4*)(kp + 4) * (1.f / MBLK);
            u32x4 p; p.x = pkh(a0[0], a0[1]); p.y = pkh(a0[2], a0[3]); p.z = pkh(a1[0], a1[1]); p.w = pkh(a1[2], a1[3]);
            g = __builtin_amdgcn_mfma_f32_32x32x16_f16(__builtin_bit_cast(f16x8, p), qf[s], g, 0, 0, 0); }
        float t0 = -INFINITY, t1 = -INFINITY, t2 = -INFINITY; int j0 = -1, j1 = -1, j2 = -1;
#pragma unroll
        for (int i = 0; i < 16; ++i) { const int jb = crow16(i, h); if (jb < blk) TOP3_INSERT(g[i], jb); }
        { const float p0 = __shfl_xor(t0, 32), p1 = __shfl_xor(t1, 32), p2 = __shfl_xor(t2, 32); const int q0_ = __shfl_xor(j0, 32), q1_ = __shfl_xor(j1, 32), q2_ = __shfl_xor(j2, 32);
          TOP3_INSERT(p0, q0_); TOP3_INSERT(p1, q1_); TOP3_INSERT(p2, q2_); }
        if (h == 0) {
            if (j0 >= 0) { const int sl = __hip_atomic_fetch_add(cnt + j0, 1, __ATOMIC_RELAXED, __HIP_MEMORY_SCOPE_WORKGROUP); qlist[j0 * 256 + sl] = (unsigned short)qlw; }
            if (j1 >= 0) { const int sl = __hip_atomic_fetch_add(cnt + j1, 1, __ATOMIC_RELAXED, __HIP_MEMORY_SCOPE_WORKGROUP); qlist[j1 * 256 + sl] = (unsigned short)(qlw | 256); }
            if (j2 >= 0) { const int sl = __hip_atomic_fetch_add(cnt + j2, 1, __ATOMIC_RELAXED, __HIP_MEMORY_SCOPE_WORKGROUP); qlist[j2 * 256 + sl] = (unsigned short)(qlw | 512); }
        }
        f32x16 x;
#pragma unroll
        for (int i = 0; i < 16; ++i) x[i] = 0.f;
#pragma unroll
        for (int s = 0; s < 4; ++s) x = __builtin_amdgcn_mfma_f32_32x32x16_f16(kd[s], qf[s], x, 0, 0, 0);
        float sd = -INFINITY;
#pragma unroll
        for (int i = 0; i < 16; ++i) sd = (crow16(i, h) == r) ? x[i] : sd;
        sd = __builtin_fmaxf(sd, __shfl_xor(sd, 32));
        if (h == 0) mref[qlw] = sd;
    }
    __syncthreads();
    {
        int total = 0;
        for (int j = 0; j < blk; ++j) total += (cnt[j] + 31) >> 5;
        total = __builtin_amdgcn_readfirstlane(total);
#pragma unroll 1
        for (int n = wave; n < total; n += NWAVES) {
            int j = 0, accg = 0;
            for (;; ++j) { const int ng = (cnt[j] + 31) >> 5; if (n < accg + ng) break; accg += ng; }
            j = __builtin_amdgcn_readfirstlane(j); const int grp = n - __builtin_amdgcn_readfirstlane(accg);
            const int cj = __builtin_amdgcn_readfirstlane(cnt[j]);
            const int li = grp * 32 + r; const bool valid = li < cj;
            const int ent = qlist[j * 256 + (valid ? li : 0)]; const int ql = ent & 255, rank = ent >> 8;
            const f16* qrow = Q + (tok0 + ql) * DM + head * HD;
            f16x8 qf[4];
#pragma unroll
            for (int s = 0; s < 4; ++s) qf[s] = *(const f16x8*)(qrow + 16 * s + 8 * h);
            const float mr = mref[ql];
            const float cb = slope2 * (float)(256 * (j - blk) - ql) - mr;
            f32x16 p0, p1;
#pragma unroll
            for (int i = 0; i < 16; ++i) { p0[i] = 0.f; p1[i] = 0.f; }
            float ps = 0.f;
#define MB_TILE(KF, VF, KT) do { \
                f32x16 x; _Pragma("unroll") for (int i = 0; i < 16; ++i) x[i] = slope2 * (float)(32 * (KT) + crow16(i, h)) + cb; \
                _Pragma("unroll") for (int s = 0; s < 4; ++s) x = __builtin_amdgcn_mfma_f32_32x32x16_f16(KF[s], qf[s], x, 0, 0, 0); \
                _Pragma("unroll") for (int i = 0; i < 16; ++i) { x[i] = __builtin_amdgcn_exp2f(x[i]); ps += x[i]; } \
                const bf16x8 pb0 = pack8b(x, 0), pb1 = pack8b(x, 1); \
                p0 = __builtin_amdgcn_mfma_f32_32x32x16_bf16(VF[0], pb0, p0, 0, 0, 0); p0 = __builtin_amdgcn_mfma_f32_32x32x16_bf16(VF[1], pb1, p0, 0, 0, 0); \
                p1 = __builtin_amdgcn_mfma_f32_32x32x16_bf16(VF[2], pb0, p1, 0, 0, 0); p1 = __builtin_amdgcn_mfma_f32_32x32x16_bf16(VF[3], pb1, p1, 0, 0, 0); } while (0)
            f16x8 kA[4], kB[4]; bf16x8 vA[4], vB[4];
            const size_t T0 = (size_t)j * 8;
            MB_LOAD(kA, vA, T0);
#pragma unroll 1
            for (int kt = 0; kt < 8; kt += 2) {
                MB_LOAD(kB, vB, T0 + kt + 1);
                __builtin_amdgcn_sched_barrier(0);
                MB_TILE(kA, vA, kt);
                MB_LOAD(kA, vA, T0 + (kt + 2 < 8 ? kt + 2 : 7));
                __builtin_amdgcn_sched_barrier(0);
                MB_TILE(kB, vB, kt + 1);
            }
#undef MB_TILE
            if (valid) {
                LAS unsigned char* sp = slots + (ql * 3 + rank) * MB_SLP + 8 * h;
#pragma unroll
                for (int g4 = 0; g4 < 4; ++g4) { u32x2 w0, w1; w0.x = pkb(p0[4 * g4], p0[4 * g4 + 1]); w0.y = pkb(p0[4 * g4 + 2], p0[4 * g4 + 3]); w1.x = pkb(p1[4 * g4], p1[4 * g4 + 1]); w1.y = pkb(p1[4 * g4 + 2], p1[4 * g4 + 3]);
                    *(LAS u32x2*)(sp + 16 * g4) = w0; *(LAS u32x2*)(sp + 64 + 16 * g4) = w1; }
                const float pst = ps + __shfl_xor(ps, 32);
                if (h == 0) sll[ql * 3 + rank] = pst;
            }
        }
    }
    __syncthreads();
    {
        const f16* qrow = Q + (tok0 + qlw) * DM + head * HD;
        f16x8 qf[4];
#pragma unroll
        for (int s = 0; s < 4; ++s) qf[s] = *(const f16x8*)(qrow + 16 * s + 8 * h);
        f32x16 o0, o1; float m = -1e30f, l = 0.f;
#pragma unroll
        for (int i = 0; i < 16; ++i) { o0[i] = 0.f; o1[i] = 0.f; }
#define MB_OWN(KF, VF, KT) do { \
            f32x16 x; _Pragma("unroll") for (int i = 0; i < 16; ++i) x[i] = slope2 * (float)(32 * (KT) + crow16(i, h) - qlw); \
            _Pragma("unroll") for (int s = 0; s < 4; ++s) x = __builtin_amdgcn_mfma_f32_32x32x16_f16(KF[s], qf[s], x, 0, 0, 0); \
            if ((KT) == wave) { _Pragma("unroll") for (int i = 0; i < 16; ++i) if (crow16(i, h) > r) x[i] = -INFINITY; } \
            float tm = x[0]; _Pragma("unroll") for (int i = 1; i < 16; ++i) tm = __builtin_fmaxf(tm, x[i]); \
            tm = __builtin_fmaxf(tm, __shfl_xor(tm, 32)); \
            const float mn = __builtin_fmaxf(m, tm); const float al = __builtin_amdgcn_exp2f(m - mn); m = mn; \
            float ps = 0.f; _Pragma("unroll") for (int i = 0; i < 16; ++i) { x[i] = __builtin_amdgcn_exp2f(x[i] - mn); ps += x[i]; } \
            l = l * al + ps; \
            _Pragma("unroll") for (int i = 0; i < 16; ++i) { o0[i] *= al; o1[i] *= al; } \
            const bf16x8 pb0 = pack8b(x, 0), pb1 = pack8b(x, 1); \
            o0 = __builtin_amdgcn_mfma_f32_32x32x16_bf16(VF[0], pb0, o0, 0, 0, 0); o0 = __builtin_amdgcn_mfma_f32_32x32x16_bf16(VF[1], pb1, o0, 0, 0, 0); \
            o1 = __builtin_amdgcn_mfma_f32_32x32x16_bf16(VF[2], pb0, o1, 0, 0, 0); o1 = __builtin_amdgcn_mfma_f32_32x32x16_bf16(VF[3], pb1, o1, 0, 0, 0); } while (0)
        {
            f16x8 kA[4], kB[4]; bf16x8 vA[4], vB[4];
            const size_t T0 = (size_t)blk * 8;
            MB_LOAD(kA, vA, T0);
#pragma unroll 1
            for (int kt = 0; kt <= wave; kt += 2) {
                MB_LOAD(kB, vB, T0 + (kt + 1 <= wave ? kt + 1 : wave));
                __builtin_amdgcn_sched_barrier(0);
                MB_OWN(kA, vA, kt);
                if (kt + 1 > wave) break;
                MB_LOAD(kA, vA, T0 + (kt + 2 <= wave ? kt + 2 : wave));
                __builtin_amdgcn_sched_barrier(0);
                MB_OWN(kB, vB, kt + 1);
            }
        }
#undef MB_OWN
        const float fsc = __builtin_amdgcn_exp2f(m - mref[qlw]);
        float lt = (l + __shfl_xor(l, 32)) * fsc;
#pragma unroll
        for (int i = 0; i < 16; ++i) { o0[i] *= fsc; o1[i] *= fsc; }
        const int nsel = blk < 3 ? blk : 3;
        for (int rk = 0; rk < nsel; ++rk) {
            const LAS unsigned char* sp = slots + (qlw * 3 + rk) * MB_SLP + 8 * h;
            lt += sll[qlw * 3 + rk];
#pragma unroll
            for (int g4 = 0; g4 < 4; ++g4) { const u32x2 w0 = *(const LAS u32x2*)(sp + 16 * g4), w1 = *(const LAS u32x2*)(sp + 64 + 16 * g4);
                o0[4 * g4] += __uint_as_float(w0.x << 16); o0[4 * g4 + 1] += __uint_as_float(w0.x & 0xffff0000u); o0[4 * g4 + 2] += __uint_as_float(w0.y << 16); o0[4 * g4 + 3] += __uint_as_float(w0.y & 0xffff0000u);
                o1[4 * g4] += __uint_as_float(w1.x << 16); o1[4 * g4 + 1] += __uint_as_float(w1.x & 0xffff0000u); o1[4 * g4 + 2] += __uint_as_float(w1.y << 16); o1[4 * g4 + 3] += __uint_as_float(w1.y & 0xffff0000u); }
        }
        const float inv = 1.f / lt;
        f16* orow = O + (tok0 + qlw) * DM + head * HD;
#pragma unroll
        for (int g4 = 0; g4 < 4; ++g4) {
            u32x2 w0, w1; w0.x = pkh(o0[4 * g4] * inv, o0[4 * g4 + 1] * inv); w0.y = pkh(o0[4 * g4 + 2] * inv, o0[4 * g4 + 3] * inv);
            w1.x = pkh(o1[4 * g4] * inv, o1[4 * g4 + 1] * inv); w1.y = pkh(o1[4 * g4 + 2] * inv, o1[4 * g4 + 3] * inv);
            *(u32x2*)(orow + 8 * g4 + 4 * h) = w0; *(u32x2*)(orow + 32 + 8 * g4 + 4 * h) = w1;
        }
    }
#undef MB_LOAD
    __syncthreads();
}

#define RL(id) (32 * ((id) / 10) + 16 * (((id) % 10) / 5) + (((id) % 5) == 4 ? 2 : (8 * (((id) % 5) & 1) + 4 * (((id) % 5) >> 1))))
__device__ __forceinline__ float reduce20(const float (&p)[20], int lane) {
    const bool b5 = lane & 32, b4 = lane & 16, b3 = lane & 8, b2 = lane & 4, b1 = lane & 2;
    float a[10], bq[5];
#pragma unroll
    for (int v = 0; v < 10; ++v) a[v] = (b5 ? p[v + 10] : p[v]) + __shfl_xor(b5 ? p[v] : p[v + 10], 32);
#pragma unroll
    for (int v = 0; v < 5; ++v) bq[v] = (b4 ? a[v + 5] : a[v]) + __shfl_xor(b4 ? a[v] : a[v + 5], 16);
    const float c0 = (b3 ? bq[1] : bq[0]) + __shfl_xor(b3 ? bq[0] : bq[1], 8);
    const float c1 = (b3 ? bq[3] : bq[2]) + __shfl_xor(b3 ? bq[2] : bq[3], 8);
    const float c2 = bq[4] + __shfl_xor(bq[4], 8);
    const float d0 = (b2 ? c1 : c0) + __shfl_xor(b2 ? c0 : c1, 4);
    const float d1 = c2 + __shfl_xor(c2, 4);
    const float e = (b1 ? d1 : d0) + __shfl_xor(b1 ? d0 : d1, 2);
    return e + __shfl_xor(e, 1);
}
#define RDL(f, id) __uint_as_float(__builtin_amdgcn_readlane(__float_as_uint(f), RL(id)))

constexpr int N_PHASES = 16;
struct Args { const float* in[22]; float* out; unsigned char* ws; int ph_lo, ph_hi, bar_region, pad; };
__global__ void __launch_bounds__(NTHREADS, 2) mk_fwd(Args args) {
    extern __shared__ __attribute__((aligned(16))) unsigned char lds_raw[];
    LAS unsigned char* lds = (LAS unsigned char*)lds_raw;
    volatile LAS unsigned* MISC = (volatile LAS unsigned*)(lds + MISC_OFF);
    const int tid = threadIdx.x, lane = tid & 63, wave = __builtin_amdgcn_readfirstlane(tid >> 6);
    const int G = gridDim.x; const int bx = blockIdx.x; const int vcu = (G % 8 == 0) ? (bx % 8) * (G / 8) + bx / 8 : bx;
    const int gw = vcu * NWAVES + wave, NGW = G * NWAVES;
    unsigned* ctl = (unsigned*)(args.ws + WS_CTL);
#define XIN (args.in[0])
#define CIN (args.in[1])
#define w_ada (args.in[2])
#define b_ada (args.in[3])
#define g_attn (args.in[4])
#define g_ffn (args.in[5])
#define w_qkv_a (args.in[6])
#define w_o_a (args.in[7])
#define w_ada_kv (args.in[8])
#define b_ada_kv (args.in[9])
#define g_kv (args.in[10])
#define w_kv (args.in[11])
#define w_q_b (args.in[12])
#define w_o_b (args.in[13])
#define w_rg (args.in[14])
#define b_rg (args.in[15])
#define w_re (args.in[16])
#define b_re (args.in[17])
#define w_gate (args.in[18])
#define w_up (args.in[19])
#define w_down (args.in[20])
#define g_final (args.in[21])
#define out (args.out)
#define mod ((float*)(args.ws + WS_MOD))
#define modkv (mod + 2 * 4 * 6144)
#define list ((int*)(args.ws + WS_LIST))
#define cw ((float*)(args.ws + WS_CW))
#define kms ((float*)(args.ws + WS_KMS))
#define Wqkv0 ((f16*)(args.ws + WS_WQKV0))
#define Wo0 ((f16*)(args.ws + WS_WO0))
#define Wkv1 ((f16*)(args.ws + WS_WKV1))
#define Wq1 ((f16*)(args.ws + WS_WQ1))
#define Wo1 ((f16*)(args.ws + WS_WO1))
#define Wgu ((f16*)(args.ws + WS_WGU))
#define Wd2 ((f16*)(args.ws + WS_WD2))
#define A1 ((f16*)(args.ws + WS_A1))
#define A2 ((f16*)(args.ws + WS_A2))
#define A3 ((f16*)(args.ws + WS_A3))
#define A4 ((f16*)(args.ws + WS_A4))
#define A5 ((f16*)(args.ws + WS_A5))
#define HID ((f16*)out)
#define XR ((f16*)(args.ws + WS_XR))
#define ccnt ((int*)(ctl + CW_CNT))

    for (int u = tid; u < (LDS_BYTES - LDSCTL_OFF) / 4; u += NTHREADS) ((LAS unsigned*)(lds + LDSCTL_OFF))[u] = 0u;
    __syncthreads();
    const bool use_bar = (args.ph_hi - args.ph_lo) > 1;
    XcdBarrier bar; bar.bar = ctl + CW_BAR + args.bar_region * XCD_BAR_WORDS; bar.x = 0; bar.st = nullptr;
    if (use_bar) bar = xcd_barrier_post(ctl + CW_BAR + args.bar_region * XCD_BAR_WORDS, MISC + 8);
    const int lo = args.ph_lo, hi = args.ph_hi;
#define IN(k) (lo <= (k) && (k) < hi)
#define SEAM(k) do { if (IN(k) && IN((k) + 1)) xcd_barrier(bar); } while (0)
#ifndef MK_RPT_PHASE
#define MK_RPT_PHASE -1
#define MK_RPT_N 1
#endif
#ifndef MK_DBG
#define MK_DBG 0
#endif
#define RPT(k) (((k) == MK_RPT_PHASE) ? MK_RPT_N : 1)

    if (IN(0)) for (int rep_ = 0; rep_ < RPT(0); ++rep_) { if (rep_) xcd_barrier(bar);
        for (int i = gw * 64 + lane; i < NB * NBLK * DM; i += NGW * 64) kms[i] = 0.f;
        {
            LAS float* red = (LAS float*)lds;
            for (int it = vcu; it < 224; it += G) {
                if (it < 96) mod_item(CIN, w_ada, b_ada, mod, 6144, it * 64, red, tid);
                else if (it < 192) mod_item(CIN, w_ada + (size_t)DM * 6144, b_ada + 6144, mod + 4 * 6144, 6144, (it - 96) * 64, red, tid);
                else mod_item(CIN, w_ada_kv, b_ada_kv, modkv, 2048, (it - 192) * 64, red, tid);
            }
        }
        LAS float* scr = (LAS float*)(lds + 16384 + wave * 12288);
        for (int it = gw; it < 24576; it += NGW) {
            if (it < 1536) { tr_item(w_qkv_a, 3072, 64 * (it / 96), 32 * (it % 96), Wqkv0, DM, 32 * (it % 96), 0, scr, lane); continue; }
            if (it < 2048) { const int r = it - 1536; tr_item(w_o_a, DM, 64 * (r / 32), 32 * (r % 32), Wo0, DM, 32 * (r % 32), 0, scr, lane); continue; }
            if (it < 3072) { const int r = it - 2048; tr_item(w_kv, 2048, 64 * (r / 64), 32 * (r % 64), Wkv1, DM, 32 * (r % 64), 0, scr, lane); continue; }
            if (it < 3584) { const int r = it - 3072; tr_item(w_q_b, DM, 64 * (r / 32), 32 * (r % 32), Wq1, DM, 32 * (r % 32), 0, scr, lane); continue; }
            if (it < 4096) { const int r = it - 3584; tr_item(w_o_b, DM, 64 * (r / 32), 32 * (r % 32), Wo1, DM, 32 * (r % 32), 0, scr, lane); continue; }
            if (it < 12288) { const int r = it - 4096, mat = r >> 7, sub = r & 127; const int le = mat >> 1, which = mat & 1, kb = sub >> 3, nb = sub & 7;
                const float* src = (which ? w_up : w_gate) + (size_t)le * DM * EFF; const int n0 = 32 * nb;
                tr_item(src, EFF, 64 * kb, n0, Wgu + (size_t)le * 512 * DM, DM, 256 * (n0 >> 7) + 128 * which + (n0 & 127), 0, scr, lane); continue; }
            { const int r = it - 12288, mat = r >> 7, sub = r & 127; const int lc = mat >> 1, side = mat & 1, kb = sub >> 5, nb = sub & 31;
                const int layer = lc / NCLS, cls = lc % NCLS, gq = cls / 6, p = cls % 6; const int a = p < 3 ? 0 : (p < 5 ? 1 : 2), bb = p < 3 ? p + 1 : (p < 5 ? p - 1 : 3);
                const int e = gq * 4 + (side ? bb : a);
                tr_item(w_down + (size_t)(layer * NE + e) * EFF * DM, DM, 64 * kb, 32 * nb, Wd2 + (size_t)lc * DM * 512, 512, 32 * nb, 256 * side, scr, lane); }
        }
    }
    SEAM(0);
    if (IN(1)) for (int rep_ = 0; rep_ < RPT(1); ++rep_) { if (rep_) xcd_barrier(bar);
        for (int ch = gw; ch < MT / 16; ch += NGW) {
        const int row0 = ch * 16, b = row0 / SEQ; Affine A; load_affine(A, g_attn, mod + (size_t)b * 6144 + 1024, mod + (size_t)b * 6144, lane);
        for (int r = row0; r < row0 + 16; ++r) { f32x4 v[4]; const float rs = load_row(XIN + (size_t)r * DM, v, lane); store_h(A1 + (size_t)r * DM, v, rs, A, lane); } }
    }
    SEAM(1);
    if (IN(2)) for (int rep_ = 0; rep_ < RPT(2); ++rep_) { if (rep_) xcd_barrier(bar);
        { pg8::Gemm g{(const char*)A1, (const char*)Wqkv0, DM, DM, DM}; pg8::StaticOrder S; S.init(MT, 2048, G, bx, DM, DM);
          EpiQK E{A3, DM, QSCALE, A4, nullptr};
          pg8::gemm_phase<EpiQK, pg8::StaticOrder, true, false>(lds + RING_OFF, g, S, E); }
        { pg8::Gemm g{(const char*)(Wqkv0 + (size_t)2048 * DM), (const char*)A1, DM, DM, DM}; pg8::StaticOrder S; S.init(DM, MT, G, bx, DM, DM);
          EpiVf E{(unsigned short*)A5, 0};
          pg8::gemm_phase<EpiVf, pg8::StaticOrder, true, false>(lds + RING_OFF, g, S, E); }
    }
    SEAM(2);
    if (IN(3)) for (int rep_ = 0; rep_ < RPT(3); ++rep_) { if (rep_) xcd_barrier(bar); for (int item = gw; item < NB * NH * (SEQ / 32); item += NGW) sb_item(item, A3, A4, A5, A2, lane); }
    SEAM(3);
    if (IN(4)) for (int rep_ = 0; rep_ < RPT(4); ++rep_) { if (rep_) xcd_barrier(bar);
        pg8::Gemm g{(const char*)A2, (const char*)Wo0, DM, DM, DM}; pg8::StaticOrder S; S.init(MT, DM, G, bx, DM, DM);
        EpiResid E{XIN, nullptr, XR, mod + 2048, 6144};
        pg8::gemm_phase<EpiResid, pg8::StaticOrder, true, false>(lds + RING_OFF, g, S, E);
    }
    SEAM(4);
constexpr int RT_RL = LDSCTL_OFF + 1024;
#define ROUTER_PHASE(LAYER) do { \
        LAS f16* wf = (LAS f16*)lds; \
        LAS int* rl_cnt = (LAS int*)(lds + RT_RL); LAS int* rl_base = rl_cnt + 32; LAS int* rl_tok = rl_cnt + 64; LAS int* rl_cls = rl_cnt + 192; LAS int* rl_slot = rl_cnt + 320; \
        LAS float* rl_lo = (LAS float*)(rl_cnt + 448); LAS float* rl_hi = (LAS float*)(rl_cnt + 576); LAS float* bias_l = (LAS float*)(rl_cnt + 704); LAS float* red_l = (LAS float*)(rl_cnt + 736); \
        LAS float* lgs = (LAS float*)(rl_cnt + 1024) + wave * (16 * 33); \
        const float* wrg = w_rg + (LAYER) * DM * 4; const float* wre = w_re + (LAYER) * DM * 16; \
        const float* md = mod + (size_t)(LAYER) * 4 * 6144; const float* gf_ = g_ffn + (LAYER) * DM; \
        const int bwg = (vcu * 128) / SEQ;                                         \
        if (tid < NCLS) rl_cnt[tid] = 0; \
        for (int i_ = tid; i_ < 32 * 2 * 64 * 8 / 2; i_ += NTHREADS) { const int ks_ = i_ >> 9, rem_ = i_ & 511; ((LAS unsigned*)wf)[((ks_ * 4 + 2) * 64 * 8) / 2 + rem_] = 0u; } \
        __syncthreads(); \
        { float pb[20]; _Pragma("unroll") for (int o = 0; o < 20; ++o) pb[o] = 0.f; \
          _Pragma("unroll") for (int kk = 0; kk < 2; ++kk) { const int k = tid * 2 + kk; const float av = gf_[k] * (1.f + md[(size_t)bwg * 6144 + 4096 + k]), sv = md[(size_t)bwg * 6144 + 3072 + k]; \
            const int ks_ = k >> 5, kg_ = (k >> 3) & 3, j_ = k & 7; \
            _Pragma("unroll") for (int o = 0; o < 20; ++o) { const float wv = o < 4 ? wrg[k * 4 + o] : wre[k * 16 + o - 4]; pb[o] += sv * wv; \
                const float wp = av * wv; const f16 whi = (f16)wp; const f16 wlo = (f16)(wp - (float)whi); \
                const int ct_ = o < 4 ? 1 : 0, cl_ = o < 4 ? o : o - 4; \
                wf[((ks_ * 4 + ct_ * 2 + 0) * 64 + kg_ * 16 + cl_) * 8 + j_] = whi; wf[((ks_ * 4 + ct_ * 2 + 1) * 64 + kg_ * 16 + cl_) * 8 + j_] = wlo; } } \
          const float fr_ = reduce20(pb, lane); \
          { const int vi_ = (lane & 2) ? 4 : (((lane >> 3) & 1) + 2 * ((lane >> 2) & 1)); const int id_ = 10 * ((lane >> 5) & 1) + 5 * ((lane >> 4) & 1) + vi_; \
            const bool hold_ = !(lane & 1) && (!(lane & 2) || !(lane & 12)); if (hold_) red_l[wave * 20 + id_] = fr_; } } \
        __syncthreads(); \
        if (tid < 20) { float s_ = tid < 4 ? b_rg[(LAYER) * 4 + tid] : b_re[(LAYER) * 16 + tid - 4]; _Pragma("unroll") for (int w_ = 0; w_ < 8; ++w_) s_ += red_l[w_ * 20 + tid]; bias_l[tid] = s_; } \
        __syncthreads(); \
        for (int ch = gw; ch < MT / 16; ch += NGW) { \
        const int row0 = ch * 16, b = row0 / SEQ; const int rw = lane & 15, kg = lane >> 4; \
        const f16* xrow = XR + (size_t)(row0 + rw) * DM + 8 * kg; \
        f32x4 acc0 = {0.f, 0.f, 0.f, 0.f}, acc1 = {0.f, 0.f, 0.f, 0.f}; float ss = 0.f; \
        f16x8 xa = *(const f16x8*)xrow; \
        _Pragma("unroll 2") for (int ks = 0; ks < 32; ++ks) { \
            const int kn_ = ks < 31 ? ks + 1 : 31; const f16x8 na = *(const f16x8*)(xrow + 32 * kn_); \
            _Pragma("unroll") for (int e = 0; e < 8; ++e) { const float xf = (float)xa[e]; ss += xf * xf; } \
            const LAS f16x8* wp_ = (const LAS f16x8*)wf + (ks * 4) * 64 + lane; \
            const f16x8 b0h = wp_[0], b0l = wp_[64], b1h = wp_[128], b1l = wp_[192]; \
            acc0 = __builtin_amdgcn_mfma_f32_16x16x32_f16(xa, b0h, acc0, 0, 0, 0); acc0 = __builtin_amdgcn_mfma_f32_16x16x32_f16(xa, b0l, acc0, 0, 0, 0); \
            acc1 = __builtin_amdgcn_mfma_f32_16x16x32_f16(xa, b1h, acc1, 0, 0, 0); acc1 = __builtin_amdgcn_mfma_f32_16x16x32_f16(xa, b1l, acc1, 0, 0, 0); \
            xa = na; } \
        ss += __shfl_xor(ss, 16); ss += __shfl_xor(ss, 32); \
        const float rs = __builtin_amdgcn_rsqf(ss * (1.f / DM) + EPS);                    \
          \
        _Pragma("unroll") for (int e = 0; e < 4; ++e) { lgs[(4 * kg + e) * 33 + rw] = acc0[e]; if (rw < 4) lgs[(4 * kg + e) * 33 + 16 + rw] = acc1[e]; } \
        asm volatile("s_waitcnt lgkmcnt(0)" ::: "memory"); \
        int mycls = 0; float mylo = 0.f, myhi = 0.f; \
        { const LAS float* lr = lgs + rw * 33; \
          float lg[4]; _Pragma("unroll") for (int i = 0; i < 4; ++i) lg[i] = rs * lr[16 + i] + bias_l[i]; \
          int gs = 0; float mx = lg[0]; \
          _Pragma("unroll") for (int i = 1; i < 4; ++i) if (lg[i] > mx) { mx = lg[i]; gs = i; } \
          float den = 0.f; _Pragma("unroll") for (int i = 0; i < 4; ++i) den += __expf(lg[i] - mx); \
          const float pg = 1.f / den; \
          float le[4]; _Pragma("unroll") for (int i = 0; i < 4; ++i) le[i] = rs * lr[gs * 4 + i] + bias_l[4 + gs * 4 + i]; \
          int a0 = 0; float va = le[0]; \
          _Pragma("unroll") for (int i = 1; i < 4; ++i) if (le[i] > va) { va = le[i]; a0 = i; } \
          int a1 = -1; float vb = -INFINITY; \
          _Pragma("unroll") for (int i = 0; i < 4; ++i) if (i != a0 && le[i] > vb) { vb = le[i]; a1 = i; } \
          const float e1_ = __expf(vb - va), dn = 1.f / (1.f + e1_); const float c0 = pg * dn, c1 = pg * e1_ * dn; \
          const int ea = a0 < a1 ? a0 : a1, eb = a0 < a1 ? a1 : a0; mylo = a0 < a1 ? c0 : c1; myhi = a0 < a1 ? c1 : c0; \
          mycls = gs * 6 + (ea * (7 - ea)) / 2 + (eb - ea - 1); } \
          \
        { const float* ap_ = gf_ + 8 * kg; const float* scp_ = md + (size_t)b * 6144 + 4096 + 8 * kg; const float* shp_ = md + (size_t)b * 6144 + 3072 + 8 * kg; f16* hrow = A1 + (size_t)(row0 + rw) * DM + 8 * kg; \
          _Pragma("unroll 2") for (int ks = 0; ks < 32; ++ks) { \
            const f16x8 xh_ = *(const f16x8*)(xrow + 32 * ks); const f32x4 x0 = {(float)xh_[0], (float)xh_[1], (float)xh_[2], (float)xh_[3]}, x1 = {(float)xh_[4], (float)xh_[5], (float)xh_[6], (float)xh_[7]}; \
            const f32x4 g0 = *(const f32x4*)(ap_ + 32 * ks), g1 = *(const f32x4*)(ap_ + 32 * ks + 4), c0_ = *(const f32x4*)(scp_ + 32 * ks), c1_ = *(const f32x4*)(scp_ + 32 * ks + 4); \
            const f32x4 s0 = *(const f32x4*)(shp_ + 32 * ks), s1 = *(const f32x4*)(shp_ + 32 * ks + 4); \
            const f32x4 h0 = x0 * rs * (g0 * (c0_ + 1.0f)) + s0, h1 = x1 * rs * (g1 * (c1_ + 1.0f)) + s1; \
            u32x4 w_; w_.x = pkh(h0[0], h0[1]); w_.y = pkh(h0[2], h0[3]); w_.z = pkh(h1[0], h1[1]); w_.w = pkh(h1[2], h1[3]); \
            *(u32x4*)(hrow + 32 * ks) = w_; } } \
          \
        if (lane < 16) { const int e_ = wave * 16 + lane; const int ls_ = __hip_atomic_fetch_add(rl_cnt + mycls, 1, __ATOMIC_RELAXED, __HIP_MEMORY_SCOPE_WORKGROUP); \
            rl_tok[e_] = row0 + lane; rl_cls[e_] = mycls; rl_slot[e_] = ls_; rl_lo[e_] = mylo; rl_hi[e_] = myhi; } \
        __syncthreads(); \
        if (tid < NCLS) { const int n_ = rl_cnt[tid]; rl_base[tid] = n_ ? atomicAdd(ccnt + ((LAYER) * NCLS + tid) * 64, n_) : 0; } \
        __syncthreads(); \
        if (tid < 128) { const int cl_ = rl_cls[tid], tk_ = rl_tok[tid]; list[cl_ * MT + rl_base[cl_] + rl_slot[tid]] = tk_; cw[tk_ * 2] = rl_lo[tid]; cw[tk_ * 2 + 1] = rl_hi[tid]; } \
        __syncthreads(); \
        if (tid < NCLS) rl_cnt[tid] = 0; \
        __syncthreads(); } \
    } while (0)
#define MOE_TABLE(LAYER) do { \
        LAS int* tab = (LAS int*)(lds + LDSCTL_OFF); \
        if (tid == 0) { int acc_ = 0; for (int j = 0; j < NCLS; ++j) { const int cn = ccnt[((LAYER) * NCLS + j) * 64]; tab[j] = acc_; tab[32 + j] = cn; acc_ += (cn + 255) >> 8; } tab[24] = acc_; } \
        __syncthreads(); } while (0)
#define MOE1_PHASE(LAYER) do { MOE_TABLE(LAYER); \
        MoeSched S{(const LAS int*)(lds + LDSCTL_OFF), list, G, bx, (LAYER), 1}; \
        pg8::Gemm g{(const char*)A1, (const char*)Wgu, DM, DM, DM}; EpiMoe1 E{HID, cw, S}; \
        pg8::gemm_phase<EpiMoe1, MoeSched, true, true>(lds + RING_OFF, g, S, E); } while (0)
#define MOE2_PHASE(LAYER) do { MOE_TABLE(LAYER); \
        MoeSched S{(const LAS int*)(lds + LDSCTL_OFF), list, G, bx, (LAYER), 2}; \
        pg8::Gemm g{(const char*)HID, (const char*)Wd2, 512, 512, 512}; EpiMoe2 E{XR, mod + (size_t)(LAYER) * 4 * 6144 + 5120, 6144, S}; \
        pg8::gemm_phase<EpiMoe2, MoeSched, true, false>(lds + RING_OFF, g, S, E); } while (0)
    if (IN(5)) for (int rep_ = 0; rep_ < RPT(5); ++rep_) { if (rep_) xcd_barrier(bar); ROUTER_PHASE(0); }
    SEAM(5);
    if (IN(6)) for (int rep_ = 0; rep_ < RPT(6); ++rep_) { if (rep_) xcd_barrier(bar); MOE1_PHASE(0); }
    SEAM(6);
    if (IN(7)) for (int rep_ = 0; rep_ < RPT(7); ++rep_) { if (rep_) xcd_barrier(bar); MOE2_PHASE(0); }
    SEAM(7);
    if (IN(8)) for (int rep_ = 0; rep_ < RPT(8); ++rep_) { if (rep_) xcd_barrier(bar);
        for (int ch = gw; ch < MT / 16; ch += NGW) {
        const int row0 = ch * 16, b = row0 / SEQ; Affine Akv, Aq;
        load_affine(Akv, g_kv, modkv + (size_t)b * 2048 + 1024, modkv + (size_t)b * 2048, lane);
        load_affine(Aq, g_attn + DM, mod + 4 * 6144 + (size_t)b * 6144 + 1024, mod + 4 * 6144 + (size_t)b * 6144, lane);
        for (int r = row0; r < row0 + 16; ++r) { f32x4 v[4]; const float rs = load_row_h(XR + (size_t)r * DM, v, lane);
            store_h(A1 + (size_t)r * DM, v, rs, Akv, lane); store_h(A2 + (size_t)r * DM, v, rs, Aq, lane); } }
    }
    SEAM(8);
    if (IN(9)) for (int rep_ = 0; rep_ < RPT(9); ++rep_) { if (rep_) xcd_barrier(bar);
        { pg8::Gemm g{(const char*)A1, (const char*)Wkv1, DM, DM, DM}; pg8::StaticOrder S; S.init(MT, DM, G, bx, DM, DM);
          EpiQK E{nullptr, 0, 1.f, A4, kms};
          pg8::gemm_phase<EpiQK, pg8::StaticOrder, true, false>(lds + RING_OFF, g, S, E); }
        { pg8::Gemm g{(const char*)(Wkv1 + (size_t)DM * DM), (const char*)A1, DM, DM, DM}; pg8::StaticOrder S; S.init(DM, MT, G, bx, DM, DM);
          EpiVf E{(unsigned short*)A5, 1};
          pg8::gemm_phase<EpiVf, pg8::StaticOrder, true, false>(lds + RING_OFF, g, S, E); }
        { pg8::Gemm g{(const char*)A2, (const char*)Wq1, DM, DM, DM}; pg8::StaticOrder S; S.init(MT, DM, G, bx, DM, DM);
          EpiF16 E{A3, DM, 0, 0, DM, QSCALE, 0};
          pg8::gemm_phase<EpiF16, pg8::StaticOrder, true, false>(lds + RING_OFF, g, S, E); }
    }
    SEAM(9);
    if (IN(10)) for (int rep_ = 0; rep_ < RPT(10); ++rep_) { if (rep_) xcd_barrier(bar);
        if (G == 256) { const int xg = vcu >> 5, cc = vcu & 31;
#pragma unroll 1
            for (int n = 0; n < 8; ++n) { const int bh = xg * 8 + n, blk = (cc + 4 * n) & 31; moba_unit(bh / NH, bh % NH, blk, A3, A2, A4, (const __bf16*)A5, kms, lds, tid); } }
        else {
#pragma unroll 1
            for (int uu = vcu; uu < NB * NH * NBLK; uu += G) moba_unit((uu >> 5) / NH, (uu >> 5) % NH, uu & 31, A3, A2, A4, (const __bf16*)A5, kms, lds, tid); }
    }
    SEAM(10);
    if (IN(11)) for (int rep_ = 0; rep_ < RPT(11); ++rep_) { if (rep_) xcd_barrier(bar);
        pg8::Gemm g{(const char*)A2, (const char*)Wo1, DM, DM, DM}; pg8::StaticOrder S; S.init(MT, DM, G, bx, DM, DM);
        EpiResid E{nullptr, XR, XR, mod + 4 * 6144 + 2048, 6144};
        pg8::gemm_phase<EpiResid, pg8::StaticOrder, true, false>(lds + RING_OFF, g, S, E);
    }
    SEAM(11);
    if (IN(12)) for (int rep_ = 0; rep_ < RPT(12); ++rep_) { if (rep_) xcd_barrier(bar); ROUTER_PHASE(1); }
    SEAM(12);
    if (IN(13)) for (int rep_ = 0; rep_ < RPT(13); ++rep_) { if (rep_) xcd_barrier(bar); MOE1_PHASE(1); }
    SEAM(13);
    if (IN(14)) for (int rep_ = 0; rep_ < RPT(14); ++rep_) { if (rep_) xcd_barrier(bar); MOE2_PHASE(1); }
    SEAM(14);
    if (IN(15)) for (int rep_ = 0; rep_ < RPT(15); ++rep_) { if (rep_) xcd_barrier(bar);
        f32x4 gf[4];
#pragma unroll
        for (int j = 0; j < 4; ++j) gf[j] = *(const f32x4*)(g_final + 4 * lane + 256 * j);
        for (int ch = gw; ch < MT / 16; ch += NGW) { const int row0 = ch * 16;
        for (int r = row0; r < row0 + 16; ++r) { f32x4 v[4]; const float rs = load_row_h(XR + (size_t)r * DM, v, lane);
#pragma unroll
            for (int j = 0; j < 4; ++j) *(f32x4*)(out + (size_t)r * DM + 4 * lane + 256 * j) = v[j] * rs * gf[j]; } }
    }
#undef IN
#undef SEAM
#undef XIN
#undef CIN
#undef w_ada
#undef b_ada
#undef g_attn
#undef g_ffn
#undef w_qkv_a
#undef w_o_a
#undef w_ada_kv
#undef b_ada_kv
#undef g_kv
#undef w_kv
#undef w_q_b
#undef w_o_b
#undef w_rg
#undef b_rg
#undef w_re
#undef b_re
#undef w_gate
#undef w_up
#undef w_down
#undef g_final
#undef out
#undef mod
#undef modkv
#undef list
#undef cw
#undef kms
#undef Wqkv0
#undef Wo0
#undef Wkv1
#undef Wq1
#undef Wo1
#undef Wgu
#undef Wd2
#undef A1
#undef A2
#undef A3
#undef A4
#undef A5
#undef HID
#undef XR
#undef ccnt
}

extern "C" void kernel_launch(void* const* d_in, const int* in_sizes, int n_in, void* d_out, int out_size, void* d_ws, size_t ws_size, hipStream_t stream) {
    static int grid = 0;
    if (grid == 0) {
        if (n_in != 22 || out_size != MT * DM || ws_size < WS_END) { fprintf(stderr, "kernel_launch: unexpected shapes (n_in %d out %d ws %zu)\n", n_in, out_size, ws_size); grid = -1; return; }
        int dev = 0, cus = 0, per_cu = 0;
        if (hipGetDevice(&dev) != hipSuccess || hipDeviceGetAttribute(&cus, hipDeviceAttributeMultiprocessorCount, dev) != hipSuccess) { grid = -1; return; }
        if (hipFuncSetAttribute((const void*)mk_fwd, hipFuncAttributeMaxDynamicSharedMemorySize, LDS_BYTES) != hipSuccess) { fprintf(stderr, "kernel_launch: hipFuncSetAttribute failed\n"); grid = -1; return; }
        if (hipOccupancyMaxActiveBlocksPerMultiprocessor(&per_cu, (const void*)mk_fwd, NTHREADS, LDS_BYTES) != hipSuccess || per_cu < 1) { fprintf(stderr, "kernel_launch: occupancy query says %d\n", per_cu); }
        (void)hipGetLastError();
        grid = cus;
    }
    if (grid < 0) return;
    (void)hipMemsetAsync((char*)d_ws + WS_CTL, 0, CTL_ZERO_BYTES, stream);
    Args a{};
    for (int i = 0; i < 22; ++i) a.in[i] = (const float*)d_in[i];
    a.out = (float*)d_out; a.ws = (unsigned char*)d_ws;
    f16* A3 = (f16*)((char*)d_ws + WS_A3); f16* A4 = (f16*)((char*)d_ws + WS_A4); f16* A5 = (f16*)((char*)d_ws + WS_A5); float* kms = (float*)((char*)d_ws + WS_KMS);
#ifndef MK_FUSE
#define MK_FUSE 1
#endif
    int region = 0;
    auto run = [&](int lo, int hi) {
        if (MK_FUSE) { a.ph_lo = lo; a.ph_hi = hi; a.bar_region = region++; hipLaunchKernelGGL(mk_fwd, dim3(grid), dim3(NTHREADS), LDS_BYTES, stream, a); }
        else for (int p = lo; p < hi; ++p) { a.ph_lo = p; a.ph_hi = p + 1; a.bar_region = 0; hipLaunchKernelGGL(mk_fwd, dim3(grid), dim3(NTHREADS), LDS_BYTES, stream, a); }
    };
    run(0, N_PHASES);
}
```
